# Optimizing an MI355X kernel written in HIP

```python
import jax, jax.numpy as jnp
from jax import lax
import numpy as np

D_MODEL = 2048
BATCH = 2
SEQ = 8192
DEPTH = 1

CHUNK = 64
MIX_WIDTH = D_MODEL
HEAD_DIM = 64
RWKV_WIDTH = MIX_WIDTH // 2
ATT_WIDTH = MIX_WIDTH - RWKV_WIDTH
RWKV_HEADS = RWKV_WIDTH // HEAD_DIM
ATT_HEADS = ATT_WIDTH // HEAD_DIM
DECAY_LORA = 64
AAA_LORA = 64
GATE_LORA = 128
RWKV_COLS = 3 * RWKV_WIDTH + DECAY_LORA + AAA_LORA + GATE_LORA
IN_COLS = RWKV_COLS + 3 * ATT_WIDTH
LEFT_CHUNKS = 8
BAND = (LEFT_CHUNKS + 1) * CHUNK
REL_CLIP = 128
PEER_HEADS = 8
N_KEYS = 128
N_EXPERTS = N_KEYS * N_KEYS
PEER_QDIM = 256
PEER_HALF = PEER_QDIM // 2
PEER_TOPK = 16
PEER_TOKEN_BLOCK = 128
PLE_DIM = 256
NORM_EPS = 1e-6
LNX_EPS = 64e-5

kernel_name = "hybrid_rwkv7_chunkattn_peer_block"


def rms_norm(x, g):
    x32 = x.astype(jnp.float32)
    y = x32 * lax.rsqrt(jnp.mean(x32 * x32, axis=-1, keepdims=True) + NORM_EPS)
    return (y * g.astype(jnp.float32)).astype(x.dtype)


def rwkv7_mixer(z, mu, decay_up, decay_w0, iclr_up, iclr_a0, gate_up, k_k, k_a, r_k, lnx_g, lnx_b):
    B, T, _ = z.shape
    H, N = RWKV_HEADS, HEAD_DIM
    dt = z.dtype
    z_prev = jnp.pad(z[:, :-1], ((0, 0), (1, 0), (0, 0)))
    z = z + (z_prev - z) * mu
    splits = [RWKV_WIDTH, 2 * RWKV_WIDTH, 3 * RWKV_WIDTH,
              3 * RWKV_WIDTH + DECAY_LORA, 3 * RWKV_WIDTH + DECAY_LORA + AAA_LORA]
    r, k, v, wd, ad, gd = jnp.split(z, splits, axis=-1)
    w_log = -jax.nn.softplus(-(decay_w0 + jnp.tanh(wd) @ decay_up).astype(jnp.float32)) - 0.5
    w = jnp.exp(-jnp.exp(w_log)).astype(dt)
    a = jax.nn.sigmoid(iclr_a0 + ad @ iclr_up)
    g = jax.nn.sigmoid(gd) @ gate_up
    kk = (k * k_k).reshape(B, T, H, N).astype(jnp.float32)
    kk = (kk / jnp.maximum(jnp.sqrt(jnp.sum(kk * kk, -1, keepdims=True)), 1e-12)).astype(dt)
    k = k * (1.0 + (a - 1.0) * k_a)
    r_h, w_h, k_h, v_h, a_h = (t.reshape(B, T, H, N) for t in (r, w, k, v, a))

    def step(S, inp):
        r_t, w_t, k_t, v_t, kk_t, a_t = inp
        s_kk = jnp.einsum('bhvk,bhk->bhv', S, -kk_t)
        S = (S * w_t[:, :, None, :]
             + s_kk[..., None] * (kk_t * a_t)[:, :, None, :]
             + v_t[..., None] * k_t[:, :, None, :])
        return S, jnp.einsum('bhvk,bhk->bhv', S, r_t)

    tfirst = lambda t: jnp.swapaxes(t, 0, 1)
    S0 = jnp.zeros((B, H, N, N), dt)
    _, y = lax.scan(step, S0, tuple(tfirst(t) for t in (r_h, w_h, k_h, v_h, kk, a_h)))
    y = tfirst(y).astype(jnp.float32)
    mean = jnp.mean(y, -1, keepdims=True)
    var = jnp.mean(jnp.square(y - mean), -1, keepdims=True)
    y = ((y - mean) * lax.rsqrt(var + LNX_EPS)).reshape(B, T, RWKV_WIDTH)
    y = (y * lnx_g.astype(jnp.float32) + lnx_b.astype(jnp.float32)).astype(dt)
    bonus = (jnp.sum(r_h * k_h * r_k, -1, keepdims=True) * v_h).reshape(B, T, RWKV_WIDTH)
    return (y + bonus) * g


def chunk_attention(q, k, v, rel_bias):
    B, T, _ = q.shape
    H, Dh = ATT_HEADS, HEAD_DIM
    n_chunks = T // CHUNK
    pad = LEFT_CHUNKS * CHUNK
    heads = lambda t: t.reshape(B, T, H, Dh).transpose(0, 2, 1, 3)
    q = heads(q) * (Dh ** -0.5)
    k = jnp.pad(heads(k), ((0, 0), (0, 0), (pad, 0), (0, 0)))
    v = jnp.pad(heads(v), ((0, 0), (0, 0), (pad, 0), (0, 0)))
    qi = jnp.arange(CHUNK)[:, None] + pad
    kj = jnp.arange(BAND)[None, :]
    rel = jnp.clip(qi - kj, -REL_CLIP, REL_CLIP) + REL_CLIP
    bias = rel_bias[:, rel].astype(jnp.float32)

    def one_chunk(c):
        start = c * CHUNK
        q_c = lax.dynamic_slice_in_dim(q, start, CHUNK, axis=2)
        k_c = lax.dynamic_slice_in_dim(k, start, BAND, axis=2)
        v_c = lax.dynamic_slice_in_dim(v, start, BAND, axis=2)
        s = jnp.einsum('bhqd,bhkd->bhqk', q_c, k_c).astype(jnp.float32) + bias
        s = jnp.where(kj >= pad - start, s, -jnp.inf)
        pr = jax.nn.softmax(s, axis=-1).astype(v_c.dtype)
        return jnp.einsum('bhqk,bhkd->bhqd', pr, v_c)

    o = lax.map(one_chunk, jnp.arange(n_chunks))
    return o.transpose(1, 0, 3, 2, 4).reshape(B, T, H * Dh)


def peer_ffn(x, wq, sub_keys, u, v):
    B, T, D = x.shape
    M = B * T
    xf = x.reshape(M, D)
    q = (xf @ wq).reshape(M, PEER_HEADS, 2, PEER_HALF)
    s = jnp.einsum('mhid,hind->mhin', q, sub_keys).astype(jnp.float32)
    s_top, i_top = lax.top_k(s, PEER_TOPK)
    cand = s_top[:, :, 0, :, None] + s_top[:, :, 1, None, :]
    cand_idx = i_top[:, :, 0, :, None] * N_KEYS + i_top[:, :, 1, None, :]
    best, pos = lax.top_k(cand.reshape(M, PEER_HEADS, -1), PEER_TOPK)
    experts = jnp.take_along_axis(cand_idx.reshape(M, PEER_HEADS, -1), pos, axis=-1)
    gates = jax.nn.softmax(best, axis=-1).astype(x.dtype)
    n_blocks = M // PEER_TOKEN_BLOCK

    def block(args):
        xb, eb, gb = args
        act = jax.nn.gelu(jnp.einsum('tkd,td->tk', u[eb], xb))
        return jnp.einsum('tk,tkd->td', gb * act, v[eb])

    out = lax.map(block, (xf.reshape(n_blocks, PEER_TOKEN_BLOCK, D),
                          experts.reshape(n_blocks, PEER_TOKEN_BLOCK, -1),
                          gates.reshape(n_blocks, PEER_TOKEN_BLOCK, -1)))
    return out.reshape(B, T, D)


def setup_inputs(seed: int = 0) -> dict:
    key = jax.random.key(seed)
    ks = iter(jax.random.split(key, 40))

    def nrm(shape, scale):
        return jax.random.normal(next(ks), shape, jnp.float32) * scale

    def gain(shape):
        return 1.0 + nrm(shape, 0.02)

    L, D = DEPTH, D_MODEL
    return {
        "x": nrm((BATCH, SEQ, D), 1.0),
        "p": nrm((DEPTH, BATCH, SEQ, PLE_DIM), 1.0),
        "mix_norm_g": gain((L, D)),
        "w_in": nrm((L, D, IN_COLS), D ** -0.5),
        "rwkv_mu": jax.random.uniform(next(ks), (L, RWKV_COLS), jnp.float32),
        "decay_up": nrm((L, DECAY_LORA, RWKV_WIDTH), 0.1 * DECAY_LORA ** -0.5),
        "decay_w0": jax.random.uniform(next(ks), (L, RWKV_WIDTH), jnp.float32, -4.0, 1.0),
        "iclr_up": nrm((L, AAA_LORA, RWKV_WIDTH), 0.1 * AAA_LORA ** -0.5),
        "iclr_a0": nrm((L, RWKV_WIDTH), 0.1),
        "gate_up": nrm((L, GATE_LORA, RWKV_WIDTH), GATE_LORA ** -0.5),
        "k_k": 0.85 + nrm((L, RWKV_WIDTH), 0.02),
        "k_a": gain((L, RWKV_WIDTH)),
        "r_k": nrm((L, RWKV_HEADS, HEAD_DIM), 0.1),
        "lnx_g": gain((L, RWKV_WIDTH)),
        "lnx_b": nrm((L, RWKV_WIDTH), 0.01),
        "rel_bias": nrm((L, ATT_HEADS, 2 * REL_CLIP + 1), 0.1),
        "w_out": nrm((L, MIX_WIDTH, D), MIX_WIDTH ** -0.5),
        "ffn_norm_g": gain((L, D)),
        "peer_wq": nrm((L, D, PEER_HEADS * PEER_QDIM), D ** -0.5),
        "peer_sub_keys": nrm((L, PEER_HEADS, 2, N_KEYS, PEER_HALF), PEER_HALF ** -0.5),
        "peer_u": nrm((L, N_EXPERTS, D), D ** -0.5),
        "peer_v": nrm((L, N_EXPERTS, D), 0.2),
        "ple_norm_g": gain((L, D)),
        "ple_gate_w": nrm((L, D, D), D ** -0.5),
        "ple_up": nrm((L, PLE_DIM, D), PLE_DIM ** -0.5),
        "final_norm_g": gain((D,)),
    }


def reference(x, p, mix_norm_g, w_in, rwkv_mu, decay_up, decay_w0, iclr_up, iclr_a0,
              gate_up, k_k, k_a, r_k, lnx_g, lnx_b, rel_bias, w_out, ffn_norm_g,
              peer_wq, peer_sub_keys, peer_u, peer_v, ple_norm_g, ple_gate_w, ple_up,
              final_norm_g):
    h = x
    for i in range(DEPTH):
        z = rms_norm(h, mix_norm_g[i]) @ w_in[i]
        z_rwkv, z_att = z[..., :RWKV_COLS], z[..., RWKV_COLS:]
        y_rwkv = rwkv7_mixer(z_rwkv, rwkv_mu[i], decay_up[i], decay_w0[i], iclr_up[i],
                             iclr_a0[i], gate_up[i], k_k[i], k_a[i], r_k[i], lnx_g[i], lnx_b[i])
        q_a, k_a_, v_a = jnp.split(z_att, 3, axis=-1)
        y_att = chunk_attention(q_a, k_a_, v_a, rel_bias[i])
        h = h + jnp.concatenate([y_rwkv, y_att], axis=-1) @ w_out[i]
        h = h + peer_ffn(rms_norm(h, ffn_norm_g[i]), peer_wq[i], peer_sub_keys[i], peer_u[i], peer_v[i])
        gate = jax.nn.sigmoid(rms_norm(h, ple_norm_g[i]) @ ple_gate_w[i])
        h = h + gate * (p[i] @ ple_up[i])
    return rms_norm(h, final_norm_g)
```

```cpp
#include <hip/hip_runtime.h>
#include <cstdio>
#include <cstdint>

#define GAS __attribute__((address_space(1)))
#define LAS __attribute__((address_space(3)))
#define PG8_LAS __attribute__((address_space(3)))
typedef unsigned short bf16_t;
typedef short bf16x8 __attribute__((ext_vector_type(8)));
typedef float f32x4 __attribute__((ext_vector_type(4)));
typedef float f32x2 __attribute__((ext_vector_type(2)));
typedef unsigned u32x4 __attribute__((ext_vector_type(4)));
typedef unsigned u32x2 __attribute__((ext_vector_type(2)));
typedef short s16x4 __attribute__((ext_vector_type(4)));

constexpr int BATCH = 2, T = 8192, D = 2048, M = BATCH * T;
constexpr int RW = 1024, AW = 1024, HD = 64, NH = 16;
constexpr int RC = 3328, INC = 6400, ACOLS = 3072;
constexpr int LORA_K = 256, LORA_N = 3072;
constexpr int PH = 8, NKEYS = 128, NEXP = 16384, TOPK = 16, PLE = 256;
constexpr float NORM_EPS = 1e-6f, LNX_EPS = 64e-5f;

namespace pg8 {
constexpr int BM = 256, BK = 64, HALF = 128, HTB = HALF * BK * 2  , STAGE_BYTES = 8 * HTB, NXCD = 8, WGM = 8;
__host__ __device__ __forceinline__ int lds_byte(int r, int c) { const int st = (r >> 4) * 2 + (c >> 5), rr = r & 15, cc = c & 31, ob = rr * 64 + cc * 2; return st * 1024 + (ob ^ (((ob >> 9) & 1) << 5)); }
__host__ __device__ __forceinline__ void stage_rc(int b, int& R, int& C) { const int st = b / 1024, sb = b % 1024, swz = sb ^ (((sb >> 9) & 1) << 5); R = (st >> 1) * 16 + swz / 64; C = (st & 1) * 32 + (swz % 64) / 2; }
__host__ __device__ __forceinline__ int perm32(int rho) { const int n = rho >> 4, i = rho & 15; return 8 * (i >> 2) + 4 * n + (i & 3); }

struct Unit { int pm, pn; };
struct Gemm { const bf16_t* A; const bf16_t* Bt; int M, N, K, lda; };

struct StaticOrder {
    int nM, nN, nwg, G, c;
    __host__ __device__ void init(int M, int N, int G_, int c_) { nM = M / BM; nN = N / BM; nwg = nM * nN; G = G_; c = c_; }
    __host__ __device__ bool next(int i, Unit& u) const {
        const long L = (long)i * G + c; if (L >= nwg) return false;
        int wgid = (int)L; { const int q = nwg / NXCD, r = nwg % NXCD, xcd = wgid % NXCD, off = wgid / NXCD; wgid = (xcd < r ? xcd * (q + 1) : r * (q + 1) + (xcd - r) * q) + off; }
        const int nig = WGM * nN, gid = wgid / nig, fm = gid * WGM, gsz = (nM - fm) < WGM ? (nM - fm) : WGM;
        u.pm = fm + ((wgid % nig) % gsz); u.pn = (wgid % nig) / gsz; return true;
    }
    __device__ __forceinline__ void a_ready(const Unit&) const {}
    __device__ __forceinline__ void done(const Unit&) const {}
};
__device__ __forceinline__ unsigned cvt_pk_bf16(float lo, float hi) { unsigned r; asm volatile("v_cvt_pk_bf16_f32 %0, %1, %2" : "=v"(r) : "v"(lo), "v"(hi)); return r; }

template <class Epi, class Sched, bool ALIGN_EPI = false, bool SP2 = false>
__device__ __forceinline__ void gemm_phase(PG8_LAS unsigned char* lds, const Gemm g, const Sched& S, const Epi& E) {
    int tid = threadIdx.x; asm volatile("" : "+v"(tid));
    const int wid = __builtin_amdgcn_readfirstlane(tid >> 6), lane = tid & 63, wr = wid >> 2, wc = wid & 3, fr = lane & 15, fq = lane >> 4;
    const int K = g.K, nt = K / BK;
    unsigned voffA[2], voffB[2];
#pragma unroll
    for (int i = 0; i < 2; ++i) { int R, C; stage_rc(tid * 16 + i * 8192, R, C); const int Rb = Epi::PERM ? ((R & ~31) + perm32(R & 31)) : R;
        voffA[i] = (unsigned)(R * g.lda + C) * 2u; voffB[i] = (unsigned)(Rb * K + C) * 2u; }
    const size_t kstep = (size_t)(BK * 2);
    const size_t hstepA = (size_t)HALF * g.lda * 2, hstepB = (size_t)HALF * K * 2;
    const size_t tstepA = 2 * hstepA, tstepB = 2 * hstepB;
    const unsigned ldsw = (unsigned)wid * 1024u;
    const int aoff = lds_byte(wr * 64 + fr, fq * 8), boff = lds_byte(wc * 32 + fr, fq * 8);
#define PG8_SA(b, h) (((b) * 2 + (h)) * HTB)
#define PG8_SB(b, h) ((4 + (b) * 2 + (h)) * HTB)
#define PG8_STAGE(bufoff, gbase, voff) do { _Pragma("unroll") for (int _i = 0; _i < 2; ++_i) \
        __builtin_amdgcn_global_load_lds((const unsigned*)((const char*)(gbase) + (voff)[_i]), (PG8_LAS unsigned*)(lds + (bufoff) + ldsw + _i * 8192), 16, 0, 0); } while (0)
#define PG8_LDA(dst, b, h) do { _Pragma("unroll") for (int m = 0; m < 4; ++m) _Pragma("unroll") for (int k = 0; k < 2; ++k) dst[m][k] = *(const PG8_LAS bf16x8*)(lds + PG8_SA(b, h) + aoff + m * 2048 + k * 1024); } while (0)
#define PG8_LDB(dst, b, h) do { _Pragma("unroll") for (int n = 0; n < 2; ++n) _Pragma("unroll") for (int k = 0; k < 2; ++k) dst[n][k] = *(const PG8_LAS bf16x8*)(lds + PG8_SB(b, h) + boff + n * 2048 + k * 1024); } while (0)
#define PG8_MMA(ai, bj, At, Bt) do { __builtin_amdgcn_s_setprio(1); _Pragma("unroll") for (int m = 0; m < 4; ++m) _Pragma("unroll") for (int n = 0; n < 2; ++n) _Pragma("unroll") for (int k = 0; k < 2; ++k) \
        acc[ai][bj][m][n] = __builtin_amdgcn_mfma_f32_16x16x32_bf16(Bt[n][k], At[m][k], acc[ai][bj][m][n], 0, 0, 0); __builtin_amdgcn_s_setprio(0); } while (0)
#define PG8_WAIT_V(n) asm volatile("s_waitcnt vmcnt(" #n ")" ::: "memory")
#define PG8_WAIT_L(n) asm volatile("s_waitcnt lgkmcnt(" #n ")" ::: "memory")
#define PG8_BAR __builtin_amdgcn_s_barrier()
#define PG8_SCHED __builtin_amdgcn_sched_barrier(0)
    Unit cur, nxt; int ui = 0;
    if (!S.next(0, cur)) return;
    f32x4 acc[2][2][4][2];
#pragma unroll
    for (int a = 0; a < 2; ++a)
#pragma unroll
        for (int b = 0; b < 2; ++b)
#pragma unroll
            for (int m = 0; m < 4; ++m)
#pragma unroll
                for (int n = 0; n < 2; ++n) acc[a][b][m][n] = (f32x4){0.f, 0.f, 0.f, 0.f};
    bf16x8 At[4][2], B0[2][2], B1[2][2];
    const char* cA = (const char*)g.A + (size_t)cur.pm * tstepA; const char* cB = (const char*)g.Bt + (size_t)cur.pn * tstepB;
    S.a_ready(cur);
    if constexpr (SP2) {
        PG8_STAGE(PG8_SB(0, 0), cB, voffB); PG8_STAGE(PG8_SB(0, 1), cB + hstepB, voffB); PG8_STAGE(PG8_SA(0, 0), cA, voffA); PG8_STAGE(PG8_SA(0, 1), cA + hstepA, voffA);
        if (wr == 1) PG8_BAR;
        PG8_WAIT_V(2); PG8_BAR;
        PG8_STAGE(PG8_SB(1, 0), cB + kstep, voffB); PG8_STAGE(PG8_SA(1, 0), cA + kstep, voffA); PG8_STAGE(PG8_SB(1, 1), cB + hstepB + kstep, voffB);
        PG8_WAIT_V(6); PG8_BAR;
    } else {
        PG8_STAGE(PG8_SB(0, 0), cB, voffB); PG8_STAGE(PG8_SA(0, 0), cA, voffA); PG8_STAGE(PG8_SB(0, 1), cB + hstepB, voffB); PG8_STAGE(PG8_SA(0, 1), cA + hstepA, voffA);
        if (wr == 1) PG8_BAR;
        PG8_WAIT_V(4); PG8_BAR;
        PG8_STAGE(PG8_SB(1, 0), cB + kstep, voffB); PG8_STAGE(PG8_SA(1, 0), cA + kstep, voffA); PG8_STAGE(PG8_SB(1, 1), cB + hstepB + kstep, voffB);
        PG8_WAIT_V(6); PG8_BAR;
    }
    for (;;) {
        const bool has_next = S.next(ui + 1, nxt);
        const char* nA = has_next ? (const char*)g.A + (size_t)nxt.pm * tstepA : cA; const char* nB = has_next ? (const char*)g.Bt + (size_t)nxt.pn * tstepB : cB;
        for (int t = 0; t < nt; t += 2) {
            const bool last = (t == nt - 2);
            const char* a1 = cA + (size_t)(t + 1) * kstep;
            const char* a2 = last ? nA : cA + (size_t)(t + 2) * kstep; const char* b2 = last ? nB : cB + (size_t)(t + 2) * kstep;
            const char* a3 = a2 + kstep; const char* b3 = b2 + kstep;
            if (last && has_next) S.a_ready(nxt);
            if constexpr (SP2) {
            PG8_LDB(B0, 0, 0); PG8_LDB(B1, 0, 1); PG8_SCHED; PG8_LDA(At, 0, 0); PG8_STAGE(PG8_SA(1, 1), a1 + hstepA, voffA);
            PG8_WAIT_V(8); PG8_WAIT_L(0); PG8_BAR; PG8_MMA(0, 0, At, B0); PG8_MMA(0, 1, At, B1); PG8_BAR; PG8_SCHED;
            PG8_LDA(At, 0, 1); PG8_STAGE(PG8_SB(0, 0), b2, voffB); PG8_STAGE(PG8_SB(0, 1), b2 + hstepB, voffB); PG8_STAGE(PG8_SA(0, 0), a2, voffA);
            PG8_WAIT_V(8); PG8_WAIT_L(0); PG8_BAR; PG8_MMA(1, 0, At, B0); PG8_MMA(1, 1, At, B1); PG8_BAR; PG8_SCHED;
            PG8_LDB(B0, 1, 0); PG8_LDB(B1, 1, 1); PG8_SCHED; PG8_LDA(At, 1, 0); PG8_STAGE(PG8_SA(0, 1), a2 + hstepA, voffA);
            PG8_WAIT_V(8); PG8_WAIT_L(0); PG8_BAR; PG8_MMA(0, 0, At, B0); PG8_MMA(0, 1, At, B1); PG8_BAR; PG8_SCHED;
            PG8_LDA(At, 1, 1); PG8_STAGE(PG8_SB(1, 0), b3, voffB); PG8_STAGE(PG8_SB(1, 1), b3 + hstepB, voffB); PG8_STAGE(PG8_SA(1, 0), a3, voffA);
            PG8_WAIT_V(8); PG8_WAIT_L(0); PG8_BAR; PG8_MMA(1, 0, At, B0); PG8_MMA(1, 1, At, B1); PG8_BAR; PG8_SCHED;
            } else {
            PG8_LDB(B0, 0, 0); PG8_SCHED; PG8_LDA(At, 0, 0); PG8_STAGE(PG8_SA(1, 1), a1 + hstepA, voffA);
            PG8_WAIT_L(8); PG8_BAR; PG8_WAIT_L(0); PG8_MMA(0, 0, At, B0); PG8_BAR; PG8_SCHED;
            PG8_LDB(B1, 0, 1); PG8_STAGE(PG8_SB(0, 0), b2, voffB);
            PG8_BAR; PG8_WAIT_L(0); PG8_MMA(0, 1, At, B1); PG8_BAR;
            PG8_LDA(At, 0, 1); PG8_STAGE(PG8_SA(0, 0), a2, voffA);
            PG8_BAR; PG8_WAIT_L(0); PG8_MMA(1, 0, At, B0); PG8_BAR; PG8_SCHED;
            PG8_STAGE(PG8_SB(0, 1), b2 + hstepB, voffB);
            PG8_WAIT_V(6); PG8_BAR; PG8_MMA(1, 1, At, B1); PG8_BAR;
            PG8_LDB(B0, 1, 0); PG8_SCHED; PG8_LDA(At, 1, 0); PG8_STAGE(PG8_SA(0, 1), a2 + hstepA, voffA);
            PG8_WAIT_L(8); PG8_BAR; PG8_WAIT_L(0); PG8_MMA(0, 0, At, B0); PG8_BAR; PG8_SCHED;
            PG8_LDB(B1, 1, 1); PG8_STAGE(PG8_SB(1, 0), b3, voffB);
            PG8_BAR; PG8_WAIT_L(0); PG8_MMA(0, 1, At, B1); PG8_BAR;
            PG8_LDA(At, 1, 1); PG8_STAGE(PG8_SA(1, 0), a3, voffA);
            PG8_BAR; PG8_WAIT_L(0); PG8_MMA(1, 0, At, B0); PG8_BAR; PG8_SCHED;
            PG8_STAGE(PG8_SB(1, 1), b3 + hstepB, voffB);
            PG8_WAIT_V(6); PG8_BAR; PG8_MMA(1, 1, At, B1); PG8_BAR;
            }
        }
        if constexpr (ALIGN_EPI) { if (wr == 0) PG8_BAR; }
        if constexpr (!Epi::AFTER_DRAIN) { E(acc, cur, wr, wc, fr, fq); S.done(cur); }
        if (!has_next) break;
#pragma unroll
        for (int a = 0; a < 2; ++a)
#pragma unroll
            for (int b = 0; b < 2; ++b)
#pragma unroll
                for (int m = 0; m < 4; ++m)
#pragma unroll
                    for (int n = 0; n < 2; ++n) acc[a][b][m][n] = (f32x4){0.f, 0.f, 0.f, 0.f};
        cur = nxt; cA = nA; cB = nB; ++ui;
        if constexpr (ALIGN_EPI) { if (wr == 1) PG8_BAR; }
    }
    PG8_WAIT_V(0);
    if constexpr (!ALIGN_EPI) { if (wr == 0) PG8_BAR; }
    PG8_BAR;
    if constexpr (Epi::AFTER_DRAIN) { E.fused(acc, cur, wr, wc, fr, fq, lds, wid, lane); S.done(cur); }
#undef PG8_SA
#undef PG8_SB
#undef PG8_STAGE
#undef PG8_LDA
#undef PG8_LDB
#undef PG8_MMA
#undef PG8_WAIT_V
#undef PG8_WAIT_L
#undef PG8_BAR
#undef PG8_SCHED
}
}

constexpr size_t MiB = 1u << 20;
constexpr size_t WS_CTL = 0, CTL_ZERO_BYTES = 1 * MiB;
constexpr size_t OFF_SS2 = 256 * 1024, OFF_SS4 = 320 * 1024;
constexpr size_t WS_RS1 = 1 * MiB, WS_RS3 = 1 * MiB + 64 * 1024;
constexpr size_t WS_WIN = 2 * MiB, WS_WOUT = 27 * MiB, WS_WS = 35 * MiB, WS_WG = 43 * MiB, WS_PUP = 51 * MiB, WS_LORA = 52 * MiB, WS_PB = 54 * MiB;
constexpr size_t WS_XB = 62 * MiB;
constexpr size_t WS_ZR = 126 * MiB;
constexpr size_t WS_EIDX = 190 * MiB, WS_GATES = 198 * MiB;
constexpr size_t WS_ZA = 230 * MiB;
constexpr size_t WS_VB = 294 * MiB;
constexpr size_t WS_ZS = 326 * MiB;
constexpr size_t WS_S = 358 * MiB;
constexpr size_t WS_END = 486 * MiB;
constexpr int CW_BAR = 4096;

constexpr int NWAVES = 8;
constexpr int RING_BYTES = 131072;
constexpr int LDSCTL_OFF = RING_BYTES, MISC_OFF = LDSCTL_OFF + 320;
constexpr int LDS_BYTES = 147456;

typedef GAS unsigned gu32;
#define RLX_AGENT __ATOMIC_RELAXED, __HIP_MEMORY_SCOPE_AGENT
#define LDS_WAIT() asm volatile("s_waitcnt lgkmcnt(0)" ::: "memory")
#define VM_WAIT() asm volatile("s_waitcnt vmcnt(0)" ::: "memory")
__device__ __forceinline__ unsigned f2bf(float f) { unsigned u = __builtin_bit_cast(unsigned, f); return (u + 0x7fffu + ((u >> 16) & 1u)) >> 16; }
__device__ __forceinline__ unsigned pk2(float lo, float hi) { return f2bf(lo) | (f2bf(hi) << 16); }
__device__ __forceinline__ float bflo(unsigned w) { return __builtin_bit_cast(float, w << 16); }
__device__ __forceinline__ float bfhi(unsigned w) { return __builtin_bit_cast(float, w & 0xffff0000u); }
__device__ __forceinline__ float wave_sum(float v) {
#pragma unroll
    for (int o = 1; o < 64; o <<= 1) v += __shfl_xor(v, o);
    return v;
}
__device__ __forceinline__ float sigmoidf_(float x) { return 1.0f / (1.0f + __expf(-x)); }

#define XB_TMO      128
#define XB_XCNT(j)  (256  + 64 * (j))
#define XB_XSUB(j)  (1280 + 64 * (j))
#define XB_XGEN(j)  (2304 + 64 * (j))
#define XB_TOP      3328
#define XB_TOPGEN   3392
#define XCD_BAR_WORDS 3456
#define XB_SPIN_CAP (1u << 18)

__device__ __forceinline__ unsigned xb_ld(unsigned* p)              { return __hip_atomic_load(p, __ATOMIC_RELAXED, __HIP_MEMORY_SCOPE_AGENT); }
__device__ __forceinline__ unsigned xb_add(unsigned* p, unsigned v) { return __hip_atomic_fetch_add(p, v, __ATOMIC_RELAXED, __HIP_MEMORY_SCOPE_AGENT); }
__device__ __forceinline__ unsigned xb_xcc_id() { return (unsigned)__builtin_amdgcn_s_getreg((3 << 11) | 20) & 0xFu; }
#define XB_SPIN(cond, bar) do { unsigned _sp = 0; while (cond) { __builtin_amdgcn_s_sleep(1); \
    if ((++_sp & 255u) == 0u) { if (xb_ld(&(bar)[XB_TMO])) break; if (_sp > XB_SPIN_CAP) { atomicAdd(&(bar)[XB_TMO], 1u); break; } } } } while (0)

struct XcdBarrier {
    unsigned* bar; unsigned x;
    volatile LAS unsigned* st;
};

__device__ __forceinline__ XcdBarrier xcd_barrier_post(unsigned* bar, volatile LAS unsigned* st) {
    XcdBarrier b; b.bar = bar; b.x = xb_xcc_id(); b.st = st;
    if (threadIdx.x == 0) (void)xb_add(&bar[XB_XCNT(b.x)], 1u);
    return b;
}
__device__ __forceinline__ void xcd_barrier_complete(unsigned* bar, unsigned x, unsigned& nloc, unsigned& nx) {
    const unsigned G = gridDim.x * gridDim.y * gridDim.z;
    unsigned sum, cnt, mine, sp = 0u;
    for (;;) {
        sum = 0u; cnt = 0u; mine = 0u;
#pragma unroll
        for (unsigned j = 0; j < 16; ++j) { const unsigned c = xb_ld(&bar[XB_XCNT(j)]); sum += c; cnt += (c > 0u) ? 1u : 0u; mine = (j == x) ? c : mine; }
        if (sum == G) break;
        __builtin_amdgcn_s_sleep(1);
        if ((++sp & 255u) == 0u) { if (xb_ld(&bar[XB_TMO])) break; if (sp > XB_SPIN_CAP) { atomicAdd(&bar[XB_TMO], 1u); break; } }
    }
    nloc = mine > 0u ? mine : 1u; nx = cnt > 0u ? cnt : 1u;
}

__device__ __forceinline__ void xcd_barrier(const XcdBarrier& b) {
    asm volatile("s_waitcnt vmcnt(0)" ::: "memory");
    __syncthreads();
    if (threadIdx.x == 0) {
        unsigned* bar = b.bar;
        __builtin_amdgcn_s_waitcnt(0);
        unsigned nloc = b.st[0], nx = b.st[1];
        if (nloc == 0u) { xcd_barrier_complete(bar, b.x, nloc, nx); b.st[0] = nloc; b.st[1] = nx; }
        const unsigned old = xb_add(&bar[XB_XSUB(b.x)], 1u);
        const unsigned gen = old / nloc;
        if (old + 1u == (gen + 1u) * nloc) {
            __builtin_amdgcn_fence(__ATOMIC_RELEASE, "agent");
            asm volatile("s_waitcnt vmcnt(0)" ::: "memory");
            const unsigned og = xb_add(&bar[XB_TOP], 1u);
            const unsigned tg = og / nx;
            if (og + 1u == (tg + 1u) * nx) xb_add(&bar[XB_TOPGEN], 1u);
            else XB_SPIN(xb_ld(&bar[XB_TOPGEN]) == tg, bar);
            __builtin_amdgcn_fence(__ATOMIC_ACQUIRE, "agent");
            xb_add(&bar[XB_XGEN(b.x)], 1u);
            asm volatile("s_waitcnt vmcnt(0)" ::: "memory");
        } else {
            XB_SPIN(xb_ld(&bar[XB_XGEN(b.x)]) == gen, bar);
            __builtin_amdgcn_fence(__ATOMIC_ACQUIRE, "agent");
            asm volatile("s_waitcnt vmcnt(0)" ::: "memory");
        }
    }
    __syncthreads();
}


__device__ __forceinline__ void p0_transpose_item(const float* W, int K, int N, bf16_t* WT, const float* ksc, LAS float* scr, int item, int lane) {
    const int nblk = N / 32, kb = item / nblk, nb = item % nblk, k0 = 64 * kb, n0 = 32 * nb;
#pragma unroll 8
    for (int i = 0; i < 32; ++i) { const int kk = 2 * i + (lane >> 5); const float sc = ksc ? ksc[k0 + kk] : 1.0f; scr[kk * 33 + (lane & 31)] = W[(size_t)(k0 + kk) * N + n0 + (lane & 31)] * sc; }
    LDS_WAIT(); asm volatile("" ::: "memory");
    const int c = lane & 7;
#pragma unroll
    for (int j = 0; j < 4; ++j) { const int n = (lane >> 3) + 8 * j; const LAS float* s = scr + (8 * c) * 33 + n;
        u32x4 o; o.x = pk2(s[0 * 33], s[1 * 33]); o.y = pk2(s[2 * 33], s[3 * 33]); o.z = pk2(s[4 * 33], s[5 * 33]); o.w = pk2(s[6 * 33], s[7 * 33]);
        *(u32x4*)(WT + (size_t)(n0 + n) * K + k0 + 8 * c) = o; }
    LDS_WAIT(); asm volatile("" ::: "memory");
}

struct P0Args { const float *x, *p, *g1, *w_in, *decay_up, *iclr_up, *gate_up, *w_out, *g2, *wq, *sk, *g3, *wg, *ple_up;
                bf16_t *win_t, *wout_t, *ws_t, *wg_t, *pup_t, *lora_t, *xb, *pb; float* rs1; };

__device__ __forceinline__ void p0_prologue(LAS unsigned char* lds, const P0Args& a, int G, int bid) {
    const int tid = threadIdx.x, lane = tid & 63, wave = tid >> 6;
    const int gw = bid * NWAVES + wave, NGW = G * NWAVES;
    const int gt = bid * 512 + tid, NGT = G * 512;
    {
        LAS float* skl = (LAS float*)lds; LAS float* wql = (LAS float*)(lds + 128 * 129 * 4);
        for (int item = bid; item < 512; item += G) {
            const int hi = item >> 5, k0 = (item & 31) * 64;
            __syncthreads();
            for (int idx = tid; idx < 128 * 128; idx += 512) { const int n = idx >> 7, d = idx & 127; skl[n * 129 + d] = a.sk[(size_t)hi * 16384 + idx]; }
            for (int idx = tid; idx < 64 * 128; idx += 512) { const int k = idx >> 7, d = idx & 127; wql[d * 65 + k] = a.wq[(size_t)(k0 + k) * 2048 + hi * 128 + d]; }
            __syncthreads();
            const int n = tid & 127, kq = tid >> 7;
            float acc[16];
#pragma unroll
            for (int j = 0; j < 16; ++j) acc[j] = 0.f;
            for (int d = 0; d < 128; ++d) { const float s = skl[n * 129 + d];
#pragma unroll
                for (int j = 0; j < 16; ++j) acc[j] += s * wql[d * 65 + kq * 16 + j]; }
            bf16_t* o = a.ws_t + (size_t)(hi * 128 + n) * 2048 + k0 + kq * 16;
            const float* gg = a.g2 + k0 + kq * 16;
            u32x4 o0, o1;
            o0.x = pk2(acc[0] * gg[0], acc[1] * gg[1]); o0.y = pk2(acc[2] * gg[2], acc[3] * gg[3]); o0.z = pk2(acc[4] * gg[4], acc[5] * gg[5]); o0.w = pk2(acc[6] * gg[6], acc[7] * gg[7]);
            o1.x = pk2(acc[8] * gg[8], acc[9] * gg[9]); o1.y = pk2(acc[10] * gg[10], acc[11] * gg[11]); o1.z = pk2(acc[12] * gg[12], acc[13] * gg[13]); o1.w = pk2(acc[14] * gg[14], acc[15] * gg[15]);
            *(u32x4*)o = o0; *(u32x4*)(o + 8) = o1;
        }
        __syncthreads();
    }
    {
        LAS float* scr = (LAS float*)(lds + wave * 16384);
        constexpr int I_IN = (D / 64) * (INC / 32), I_SQ = (D / 64) * (D / 32), I_PU = (PLE / 64) * (D / 32);
        constexpr int NITEMS = I_IN + 2 * I_SQ + I_PU;
        for (int it = gw; it < NITEMS; it += NGW) {
            int r = it;
            if (r < I_IN) { p0_transpose_item(a.w_in, D, INC, a.win_t, a.g1, scr, r, lane); continue; } r -= I_IN;
            if (r < I_SQ) { p0_transpose_item(a.w_out, D, D, a.wout_t, nullptr, scr, r, lane); continue; } r -= I_SQ;
            if (r < I_SQ) { p0_transpose_item(a.wg, D, D, a.wg_t, a.g3, scr, r, lane); continue; } r -= I_SQ;
            p0_transpose_item(a.ple_up, PLE, D, a.pup_t, nullptr, scr, r, lane);
        }
    }
    for (int idx = gt; idx < LORA_N * LORA_K; idx += NGT) {
        const int n = idx >> 8, k = idx & 255; float v = 0.f;
        if (n < 1024) { if (k < 64) v = a.decay_up[k * 1024 + n]; }
        else if (n < 2048) { if (k >= 64 && k < 128) v = a.iclr_up[(k - 64) * 1024 + (n - 1024)]; }
        else { if (k >= 128) v = a.gate_up[(k - 128) * 1024 + (n - 2048)]; }
        a.lora_t[idx] = (bf16_t)f2bf(v);
    }
    for (int m = gw; m < M; m += NGW) {
        const f32x4* xr = (const f32x4*)(a.x + (size_t)m * D) + lane;
        f32x4 v[8]; float s = 0.f;
#pragma unroll
        for (int j = 0; j < 8; ++j) { v[j] = xr[64 * j]; s += (v[j].x * v[j].x + v[j].y * v[j].y) + (v[j].z * v[j].z + v[j].w * v[j].w); }
        s = wave_sum(s);
        if (lane == 0) a.rs1[m] = 1.0f / sqrtf(s * (1.0f / D) + NORM_EPS);
        u32x2* o8 = (u32x2*)(a.xb + (size_t)m * D) + lane;
#pragma unroll
        for (int j = 0; j < 8; ++j) { u32x2 o; o.x = pk2(v[j].x, v[j].y); o.y = pk2(v[j].z, v[j].w); o8[64 * j] = o; }
    }
    for (int idx = gt; idx < M * PLE / 8; idx += NGT) {
        const f32x4 v0 = *((const f32x4*)a.p + 2 * (size_t)idx), v1 = *((const f32x4*)a.p + 2 * (size_t)idx + 1);
        u32x4 o; o.x = pk2(v0.x, v0.y); o.y = pk2(v0.z, v0.w); o.z = pk2(v1.x, v1.y); o.w = pk2(v1.z, v1.w);
        *((u32x4*)a.pb + idx) = o;
    }
}

__device__ __forceinline__ void cvt_stream(const float* src, bf16_t* dst, size_t n8, int G, int bid) {
    for (size_t idx = (size_t)bid * 512 + threadIdx.x; idx < n8; idx += (size_t)G * 512) {
        const f32x4 v0 = *((const f32x4*)src + 2 * idx), v1 = *((const f32x4*)src + 2 * idx + 1);
        u32x4 o; o.x = pk2(v0.x, v0.y); o.y = pk2(v0.z, v0.w); o.z = pk2(v1.x, v1.y); o.w = pk2(v1.z, v1.w);
        *((u32x4*)dst + idx) = o;
    }
}

__device__ __forceinline__ void p2_shift(const bf16_t* zr, const float* mu, bf16_t* zs, int G, int bid) {
    constexpr int CH = RC / 8;
    for (int idx = bid * 512 + threadIdx.x; idx < M * CH; idx += G * 512) {
        const int m = idx / CH, c8 = idx - m * CH, t = m & (T - 1);
        const u32x4 cur = *(const u32x4*)(zr + (size_t)m * RC + c8 * 8);
        u32x4 prv = (u32x4){0u, 0u, 0u, 0u};
        if (t > 0) prv = *(const u32x4*)(zr + (size_t)(m - 1) * RC + c8 * 8);
        const f32x4 mu0 = *(const f32x4*)(mu + c8 * 8), mu1 = *(const f32x4*)(mu + c8 * 8 + 4);
        float z[8], zp[8], mm[8] = {mu0.x, mu0.y, mu0.z, mu0.w, mu1.x, mu1.y, mu1.z, mu1.w};
        z[0] = bflo(cur.x); z[1] = bfhi(cur.x); z[2] = bflo(cur.y); z[3] = bfhi(cur.y); z[4] = bflo(cur.z); z[5] = bfhi(cur.z); z[6] = bflo(cur.w); z[7] = bfhi(cur.w);
        zp[0] = bflo(prv.x); zp[1] = bfhi(prv.x); zp[2] = bflo(prv.y); zp[3] = bfhi(prv.y); zp[4] = bflo(prv.z); zp[5] = bfhi(prv.z); zp[6] = bflo(prv.w); zp[7] = bfhi(prv.w);
#pragma unroll
        for (int j = 0; j < 8; ++j) { float v = z[j] + (zp[j] - z[j]) * mm[j];
            if (c8 >= 384) { if (c8 < 392) v = tanhf(v); else if (c8 >= 400) v = sigmoidf_(v); }
            z[j] = v; }
        u32x4 o; o.x = pk2(z[0], z[1]); o.y = pk2(z[2], z[3]); o.z = pk2(z[4], z[5]); o.w = pk2(z[6], z[7]);
        *(u32x4*)(zs + (size_t)m * RC + c8 * 8) = o;
    }
}

#define EPI_LOOP_BEGIN \
    _Pragma("unroll") for (int ai = 0; ai < 2; ++ai) _Pragma("unroll") for (int m = 0; m < 4; ++m) { const int row = u.pm * 256 + ai * 128 + wr * 64 + m * 16 + fr; \
    _Pragma("unroll") for (int bj = 0; bj < 2; ++bj) { const int ct = bj * 128 + wc * 32 + 8 * fq; const f32x4 v0 = acc[ai][bj][m][0], v1 = acc[ai][bj][m][1];
#define EPI_LOOP_END } }

struct EpiZ {
    static constexpr bool PERM = true, AFTER_DRAIN = false;
    bf16_t* zr; bf16_t* za; const float* rs1;
    __device__ __forceinline__ void operator()(const f32x4 (&acc)[2][2][4][2], const pg8::Unit& u, int wr, int wc, int fr, int fq) const {
        bf16_t* base; int ld, c0;
        if (u.pn < 13) { base = zr; ld = RC; c0 = u.pn * 256; } else { base = za; ld = ACOLS; c0 = (u.pn - 13) * 256; }
        EPI_LOOP_BEGIN
            const float sc = rs1[row];
            u32x4 w; w.x = pg8::cvt_pk_bf16(v0[0] * sc, v0[1] * sc); w.y = pg8::cvt_pk_bf16(v0[2] * sc, v0[3] * sc); w.z = pg8::cvt_pk_bf16(v1[0] * sc, v1[1] * sc); w.w = pg8::cvt_pk_bf16(v1[2] * sc, v1[3] * sc);
            *(u32x4*)(base + (size_t)row * ld + c0 + ct) = w;
        EPI_LOOP_END
    }
};
struct EpiLora {
    static constexpr bool PERM = true, AFTER_DRAIN = false;
    bf16_t* law; const float* w0; const float* a0;
    __device__ __forceinline__ void operator()(const f32x4 (&acc)[2][2][4][2], const pg8::Unit& u, int wr, int wc, int fr, int fq) const {
        const int kind = u.pn >> 2;
        EPI_LOOP_BEGIN
            const int c = u.pn * 256 + ct;
            float v[8] = {v0[0], v0[1], v0[2], v0[3], v1[0], v1[1], v1[2], v1[3]};
            if (kind == 0) {
#pragma unroll
                for (int j = 0; j < 8; ++j) { const float xx = w0[c + j] + v[j]; const float sp = __logf(1.0f + __expf(-xx)); v[j] = -__expf(-sp - 0.5f); }
            } else if (kind == 1) {
#pragma unroll
                for (int j = 0; j < 8; ++j) v[j] = sigmoidf_(a0[c - 1024 + j] + v[j]);
            }
            u32x4 w; w.x = pg8::cvt_pk_bf16(v[0], v[1]); w.y = pg8::cvt_pk_bf16(v[2], v[3]); w.z = pg8::cvt_pk_bf16(v[4], v[5]); w.w = pg8::cvt_pk_bf16(v[6], v[7]);
            *(u32x4*)(law + (size_t)row * LORA_N + c) = w;
        EPI_LOOP_END
    }
};
struct EpiRes1 {
    static constexpr bool PERM = true, AFTER_DRAIN = false;
    const float* x; float* out; bf16_t* hb; float* ss;
    __device__ __forceinline__ void operator()(const f32x4 (&acc)[2][2][4][2], const pg8::Unit& u, int wr, int wc, int fr, int fq) const {
        float part[2][4];
#pragma unroll
        for (int i = 0; i < 2; ++i)
#pragma unroll
            for (int j = 0; j < 4; ++j) part[i][j] = 0.f;
        EPI_LOOP_BEGIN
            const size_t o = (size_t)row * D + u.pn * 256 + ct;
            const f32x4 x0 = *(const f32x4*)(x + o), x1 = *(const f32x4*)(x + o + 4);
            const f32x4 h0 = x0 + v0, h1 = x1 + v1;
            *(f32x4*)(out + o) = h0; *(f32x4*)(out + o + 4) = h1;
            u32x4 w; w.x = pg8::cvt_pk_bf16(h0[0], h0[1]); w.y = pg8::cvt_pk_bf16(h0[2], h0[3]); w.z = pg8::cvt_pk_bf16(h1[0], h1[1]); w.w = pg8::cvt_pk_bf16(h1[2], h1[3]);
            *(u32x4*)(hb + o) = w;
            part[ai][m] += (h0[0] * h0[0] + h0[1] * h0[1]) + (h0[2] * h0[2] + h0[3] * h0[3]) + (h1[0] * h1[0] + h1[1] * h1[1]) + (h1[2] * h1[2] + h1[3] * h1[3]);
        EPI_LOOP_END
#pragma unroll
        for (int ai = 0; ai < 2; ++ai)
#pragma unroll
            for (int m = 0; m < 4; ++m) { float p = part[ai][m]; p += __shfl_xor(p, 16); p += __shfl_xor(p, 32);
                if (fq == 0) atomicAdd(ss + u.pm * 256 + ai * 128 + wr * 64 + m * 16 + fr, p); }
    }
};
struct EpiS {
    static constexpr bool PERM = true, AFTER_DRAIN = false;
    float* s; const float* ss;
    __device__ __forceinline__ void operator()(const f32x4 (&acc)[2][2][4][2], const pg8::Unit& u, int wr, int wc, int fr, int fq) const {
        EPI_LOOP_BEGIN
            const float sc = 1.0f / sqrtf(ss[row] * (1.0f / D) + NORM_EPS);
            const size_t o = (size_t)row * D + u.pn * 256 + ct;
            *(f32x4*)(s + o) = v0 * sc; *(f32x4*)(s + o + 4) = v1 * sc;
        EPI_LOOP_END
    }
};
struct EpiBf {
    static constexpr bool PERM = true, AFTER_DRAIN = false;
    bf16_t* o; int ldc;
    __device__ __forceinline__ void operator()(const f32x4 (&acc)[2][2][4][2], const pg8::Unit& u, int wr, int wc, int fr, int fq) const {
        EPI_LOOP_BEGIN
            u32x4 w; w.x = pg8::cvt_pk_bf16(v0[0], v0[1]); w.y = pg8::cvt_pk_bf16(v0[2], v0[3]); w.z = pg8::cvt_pk_bf16(v1[0], v1[1]); w.w = pg8::cvt_pk_bf16(v1[2], v1[3]);
            *(u32x4*)(o + (size_t)row * ldc + u.pn * 256 + ct) = w;
        EPI_LOOP_END
    }
};
struct EpiGate {
    static constexpr bool PERM = true, AFTER_DRAIN = false;
    float* out; const bf16_t* pu; const float* rs3; float* ss;
    __device__ __forceinline__ void operator()(const f32x4 (&acc)[2][2][4][2], const pg8::Unit& u, int wr, int wc, int fr, int fq) const {
        float part[2][4];
#pragma unroll
        for (int i = 0; i < 2; ++i)
#pragma unroll
            for (int j = 0; j < 4; ++j) part[i][j] = 0.f;
        EPI_LOOP_BEGIN
            const size_t o = (size_t)row * D + u.pn * 256 + ct;
            const float sc = rs3[row];
            const f32x4 a0 = *(const f32x4*)(out + o), a1 = *(const f32x4*)(out + o + 4);
            const u32x4 pw = *(const u32x4*)(pu + o);
            f32x4 h0, h1;
            h0[0] = a0[0] + sigmoidf_(v0[0] * sc) * bflo(pw.x); h0[1] = a0[1] + sigmoidf_(v0[1] * sc) * bfhi(pw.x);
            h0[2] = a0[2] + sigmoidf_(v0[2] * sc) * bflo(pw.y); h0[3] = a0[3] + sigmoidf_(v0[3] * sc) * bfhi(pw.y);
            h1[0] = a1[0] + sigmoidf_(v1[0] * sc) * bflo(pw.z); h1[1] = a1[1] + sigmoidf_(v1[1] * sc) * bfhi(pw.z);
            h1[2] = a1[2] + sigmoidf_(v1[2] * sc) * bflo(pw.w); h1[3] = a1[3] + sigmoidf_(v1[3] * sc) * bfhi(pw.w);
            *(f32x4*)(out + o) = h0; *(f32x4*)(out + o + 4) = h1;
            part[ai][m] += (h0[0] * h0[0] + h0[1] * h0[1]) + (h0[2] * h0[2] + h0[3] * h0[3]) + (h1[0] * h1[0] + h1[1] * h1[1]) + (h1[2] * h1[2] + h1[3] * h1[3]);
        EPI_LOOP_END
#pragma unroll
        for (int ai = 0; ai < 2; ++ai)
#pragma unroll
            for (int m = 0; m < 4; ++m) { float p = part[ai][m]; p += __shfl_xor(p, 16); p += __shfl_xor(p, 32);
                if (fq == 0) atomicAdd(ss + u.pm * 256 + ai * 128 + wr * 64 + m * 16 + fr, p); }
    }
};

typedef short v4i16_t __attribute__((ext_vector_type(4)));
__device__ __forceinline__ s16x4 vtr(const LAS unsigned char* p) { return __builtin_bit_cast(s16x4, __builtin_amdgcn_ds_read_tr16_b64_v4i16((LAS v4i16_t*)p)); }
constexpr int VROW = 144;
__device__ __forceinline__ void attn_phase(LAS unsigned char* lds, const bf16_t* za, const float* rel_bias, bf16_t* ymix, int G, int bid) {
    const int tid = threadIdx.x, lane = tid & 63, w = tid >> 6, g = lane >> 4, i = lane & 15;
    LAS unsigned char* vl = lds;
    LAS float* biasl = (LAS float*)(lds + 96 * 1024);
    for (int unit = bid; unit < BATCH * NH * 64; unit += G) {
        const int bh = unit >> 6, cp = unit & 63, b = bh >> 4, h = bh & 15, c0 = 2 * cp;
        __syncthreads();
        if (tid < 257) biasl[tid] = rel_bias[h * 257 + tid];
        for (int idx = tid; idx < 640 * 8; idx += 512) {
            const int key = idx >> 3, ch = idx & 7, jt = c0 - 8 + (key >> 6);
            if (jt >= 0) { const size_t tok = (size_t)b * T + jt * 64 + (key & 63);
                const u32x4 v = *(const u32x4*)(za + tok * ACOLS + 2048 + h * 64 + ch * 8);
                *(LAS u32x4*)(vl + key * VROW + ch * 16) = v; }
        }
        __syncthreads();
        const int cw = c0 + (w >> 2), ql = (w & 3) * 16 + i;
        const size_t tokq = (size_t)b * T + cw * 64 + ql;
        bf16x8 qf[2];
        qf[0] = *(const bf16x8*)(za + tokq * ACOLS + h * 64 + g * 8);
        qf[1] = *(const bf16x8*)(za + tokq * ACOLS + h * 64 + 32 + g * 8);
        float m_run = -INFINITY, l = 0.f;
        f32x4 o[4];
#pragma unroll
        for (int dt = 0; dt < 4; ++dt) o[dt] = (f32x4){0.f, 0.f, 0.f, 0.f};
        const float bias_far = biasl[256];
        for (int jt = cw - 8; jt <= cw; ++jt) {
            if (jt < 0) continue;
            const int slot = jt - (c0 - 8), delta = cw - jt;
            f32x4 s[4];
#pragma unroll
            for (int t = 0; t < 4; ++t) {
                const size_t tokk = (size_t)b * T + jt * 64 + t * 16 + i;
                const bf16x8 k0 = *(const bf16x8*)(za + tokk * ACOLS + 1024 + h * 64 + g * 8);
                const bf16x8 k1 = *(const bf16x8*)(za + tokk * ACOLS + 1024 + h * 64 + 32 + g * 8);
                s[t] = __builtin_amdgcn_mfma_f32_16x16x32_bf16(k0, qf[0], (f32x4){0.f, 0.f, 0.f, 0.f}, 0, 0, 0);
                s[t] = __builtin_amdgcn_mfma_f32_16x16x32_bf16(k1, qf[1], s[t], 0, 0, 0);
            }
            float mx = -INFINITY;
#pragma unroll
            for (int t = 0; t < 4; ++t)
#pragma unroll
                for (int r = 0; r < 4; ++r) {
                    float bias = bias_far;
                    if (delta < 3) { const int kl = 16 * t + 4 * g + r; int dd = 64 * delta + ql - kl; dd = dd > 128 ? 128 : dd; bias = biasl[128 + dd]; }
                    const float v = s[t][r] * 0.125f + bias; s[t][r] = v; mx = fmaxf(mx, v);
                }
            mx = fmaxf(mx, __shfl_xor(mx, 16)); mx = fmaxf(mx, __shfl_xor(mx, 32));
            const float m_new = fmaxf(m_run, mx), f = __expf(m_run - m_new);
            l *= f;
#pragma unroll
            for (int dt = 0; dt < 4; ++dt) o[dt] = o[dt] * f;
            float ps = 0.f;
#pragma unroll
            for (int t = 0; t < 4; ++t)
#pragma unroll
                for (int r = 0; r < 4; ++r) { const float p = __expf(s[t][r] - m_new); s[t][r] = p; ps += p; }
            l += ps; m_run = m_new;
            bf16x8 pb[2];
#pragma unroll
            for (int ks = 0; ks < 2; ++ks) {
                u32x4 wv; wv.x = pk2(s[2 * ks][0], s[2 * ks][1]); wv.y = pk2(s[2 * ks][2], s[2 * ks][3]); wv.z = pk2(s[2 * ks + 1][0], s[2 * ks + 1][1]); wv.w = pk2(s[2 * ks + 1][2], s[2 * ks + 1][3]);
                pb[ks] = __builtin_bit_cast(bf16x8, wv);
            }
#pragma unroll
            for (int dt = 0; dt < 4; ++dt)
#pragma unroll
                for (int ks = 0; ks < 2; ++ks) {
                    const LAS unsigned char* p0 = vl + (slot * 64 + 32 * ks + 4 * g + (i >> 2)) * VROW + (16 * dt + 4 * (i & 3)) * 2;
                    const s16x4 lo = vtr(p0), hi = vtr(p0 + 16 * VROW);
                    const bf16x8 af = (bf16x8){lo[0], lo[1], lo[2], lo[3], hi[0], hi[1], hi[2], hi[3]};
                    o[dt] = __builtin_amdgcn_mfma_f32_16x16x32_bf16(af, pb[ks], o[dt], 0, 0, 0);
                }
        }
        l += __shfl_xor(l, 16); l += __shfl_xor(l, 32);
        const float il = 1.0f / l;
        bf16_t* orow = ymix + tokq * D + 1024 + h * 64;
#pragma unroll
        for (int dt = 0; dt < 4; ++dt) { u32x2 wv; wv.x = pk2(o[dt][0] * il, o[dt][1] * il); wv.y = pk2(o[dt][2] * il, o[dt][3] * il); *(u32x2*)(orow + 16 * dt + 4 * g) = wv; }
    }
}

struct ScanArgs { const bf16_t* zs; const bf16_t* law; const float *k_k, *k_a, *r_k, *lnx_g, *lnx_b; bf16_t* ymix; };
constexpr int TS = 32;
__device__ __forceinline__ void scan_phase(LAS unsigned char* lds, const ScanArgs& a, int G, int bid) {
    const int tid = threadIdx.x, lane = tid & 63, w = tid >> 6;
    LAS float* vec = (LAS float*)lds;
    LAS float* bon = (LAS float*)(lds + TS * 6 * 64 * 4);
    LAS float* ybuf = bon + TS;
    for (int bh = bid; bh < BATCH * NH; bh += G) {
        const int b = bh >> 4, h = bh & 15;
        const float kkc = a.k_k[h * 64 + lane], kac = a.k_a[h * 64 + lane], rkc = a.r_k[h * 64 + lane], lg = a.lnx_g[h * 64 + lane], lb = a.lnx_b[h * 64 + lane];
        float S[8];
#pragma unroll
        for (int j = 0; j < 8; ++j) S[j] = 0.f;
        const int rho = w * 8 + (lane >> 3), sg = lane & 7;
        for (int t0 = 0; t0 < T; t0 += TS) {
            __syncthreads();
            for (int s = w; s < TS; s += 8) {
                const size_t m = (size_t)b * T + t0 + s;
                const float r = bflo((unsigned)a.zs[m * RC + h * 64 + lane]), k = bflo((unsigned)a.zs[m * RC + 1024 + h * 64 + lane]), v = bflo((unsigned)a.zs[m * RC + 2048 + h * 64 + lane]);
                const float lw = bflo((unsigned)a.law[m * LORA_N + h * 64 + lane]), aa = bflo((unsigned)a.law[m * LORA_N + 1024 + h * 64 + lane]);
                const float kkr = k * kkc; const float ss = wave_sum(kkr * kkr);
                const float kk = kkr / fmaxf(sqrtf(ss), 1e-12f);
                const float kp = k * (1.0f + (aa - 1.0f) * kac);
                const float bo = wave_sum(r * kp * rkc);
                LAS float* vs = vec + s * 384;
                vs[lane] = r; vs[64 + lane] = __expf(lw); vs[128 + lane] = kp; vs[192 + lane] = v; vs[256 + lane] = -kk; vs[320 + lane] = kk * aa;
                if (lane == 0) bon[s] = bo;
            }
            __syncthreads();
            for (int s = 0; s < TS; ++s) {
                const LAS float* vs = vec + s * 384 + sg * 8;
                const f32x4 r0 = *(const LAS f32x4*)(vs), r1 = *(const LAS f32x4*)(vs + 4);
                const f32x4 w0 = *(const LAS f32x4*)(vs + 64), w1 = *(const LAS f32x4*)(vs + 68);
                const f32x4 k0 = *(const LAS f32x4*)(vs + 128), k1 = *(const LAS f32x4*)(vs + 132);
                const f32x4 n0 = *(const LAS f32x4*)(vs + 256), n1 = *(const LAS f32x4*)(vs + 260);
                const f32x4 b0 = *(const LAS f32x4*)(vs + 320), b1 = *(const LAS f32x4*)(vs + 324);
                const float vr = vec[s * 384 + 192 + rho];
                float sa = (S[0] * n0[0] + S[1] * n0[1]) + (S[2] * n0[2] + S[3] * n0[3]) + (S[4] * n1[0] + S[5] * n1[1]) + (S[6] * n1[2] + S[7] * n1[3]);
                sa += __shfl_xor(sa, 1); sa += __shfl_xor(sa, 2); sa += __shfl_xor(sa, 4);
                S[0] = S[0] * w0[0] + sa * b0[0] + vr * k0[0]; S[1] = S[1] * w0[1] + sa * b0[1] + vr * k0[1];
                S[2] = S[2] * w0[2] + sa * b0[2] + vr * k0[2]; S[3] = S[3] * w0[3] + sa * b0[3] + vr * k0[3];
                S[4] = S[4] * w1[0] + sa * b1[0] + vr * k1[0]; S[5] = S[5] * w1[1] + sa * b1[1] + vr * k1[1];
                S[6] = S[6] * w1[2] + sa * b1[2] + vr * k1[2]; S[7] = S[7] * w1[3] + sa * b1[3] + vr * k1[3];
                float y = (S[0] * r0[0] + S[1] * r0[1]) + (S[2] * r0[2] + S[3] * r0[3]) + (S[4] * r1[0] + S[5] * r1[1]) + (S[6] * r1[2] + S[7] * r1[3]);
                y += __shfl_xor(y, 1); y += __shfl_xor(y, 2); y += __shfl_xor(y, 4);
                if (sg == 0) ybuf[s * 64 + rho] = y;
            }
            __syncthreads();
            for (int s = w; s < TS; s += 8) {
                const size_t m = (size_t)b * T + t0 + s;
                const float y = ybuf[s * 64 + lane];
                const float mean = wave_sum(y) * (1.0f / 64.0f); const float dlt = y - mean;
                const float var = wave_sum(dlt * dlt) * (1.0f / 64.0f);
                const float yn = dlt / sqrtf(var + LNX_EPS);
                const float gg = bflo((unsigned)a.law[m * LORA_N + 2048 + h * 64 + lane]);
                const float outv = (yn * lg + lb + bon[s] * vec[s * 384 + 192 + lane]) * gg;
                a.ymix[m * D + h * 64 + lane] = (bf16_t)f2bf(outv);
            }
        }
    }
}

#define TK_INS(t, xin) do { float x_ = (xin); _Pragma("unroll") for (int j_ = 0; j_ < 16; ++j_) { const float hi_ = fmaxf(t[j_], x_); x_ = fminf(t[j_], x_); t[j_] = hi_; } } while (0)
__device__ __forceinline__ void topk_phase(LAS unsigned char* lds, const float* s, int* eidx, float* gates, int G, int bid) {
    const int tid = threadIdx.x;
    LAS unsigned short* el = (LAS unsigned short*)lds;
    for (int idx = bid * 512 + tid; idx < M * PH; idx += G * 512) {
        const float* sb = s + (size_t)idx * 256;
        float ta[16], tb[16], tc[16];
#pragma unroll
        for (int j = 0; j < 16; ++j) { ta[j] = -INFINITY; tb[j] = -INFINITY; tc[j] = -INFINITY; }
        for (int n4 = 0; n4 < 32; ++n4) {
            const f32x4 va = *(const f32x4*)(sb + n4 * 4), vb = *(const f32x4*)(sb + 128 + n4 * 4);
#pragma unroll
            for (int e = 0; e < 4; ++e) {
                const float fa = va[e], fb = vb[e];
                const float xa = __uint_as_float((__float_as_uint(fa) & ~127u) | (unsigned)(n4 * 4 + e));
                const float xb = __uint_as_float((__float_as_uint(fb) & ~127u) | (unsigned)(n4 * 4 + e));
                TK_INS(ta, xa); TK_INS(tb, xb);
            }
        }
        int kc = 0;
#pragma unroll
        for (int i = 0; i < 16; ++i)
#pragma unroll
            for (int j = 0; j < 16; ++j)
                if ((i + 1) * (j + 1) <= 16) {
                    const unsigned ba = __float_as_uint(ta[i]), bb = __float_as_uint(tb[j]);
                    const float sum = __uint_as_float(ba & ~127u) + __uint_as_float(bb & ~127u);
                    const float xc = __uint_as_float((__float_as_uint(sum) & ~63u) | (unsigned)kc);
                    el[kc * 512 + tid] = (unsigned short)(((ba & 127u) << 7) | (bb & 127u));
                    TK_INS(tc, xc);
                    ++kc;
                }
        float ex[16], den = 0.f;
#pragma unroll
        for (int j = 0; j < 16; ++j) { ex[j] = __expf(tc[j] - tc[0]); den += ex[j]; }
        const float inv = 1.0f / den;
        int ev[16];
#pragma unroll
        for (int j = 0; j < 16; ++j) ev[j] = (int)el[(__float_as_uint(tc[j]) & 63u) * 512 + tid];
        int* eo = eidx + (size_t)idx * 16; float* go = gates + (size_t)idx * 16;
#pragma unroll
        for (int j = 0; j < 16; j += 4) { *(int4*)(eo + j) = make_int4(ev[j], ev[j + 1], ev[j + 2], ev[j + 3]);
            *(f32x4*)(go + j) = (f32x4){ex[j] * inv, ex[j + 1] * inv, ex[j + 2] * inv, ex[j + 3] * inv}; }
    }
}

__device__ __forceinline__ float gelu_tanh(float x) { const float u = 0.7978845608028654f * (x + 0.044715f * x * x * x); const float t = 1.0f - 2.0f / (__expf(2.0f * u) + 1.0f); return 0.5f * x * (1.0f + t); }
struct GatherArgs { float* out; const float* ss2; const float* g2; const bf16_t* ub; const bf16_t* vb; const int* eidx; const float* gates; bf16_t* hb; float* rs3; };
__device__ __forceinline__ void gather_phase(const GatherArgs& a, int G, int bid) {
    const int tid = threadIdx.x, lane = tid & 63, wave = tid >> 6;
    for (int m = bid * NWAVES + wave; m < M; m += G * NWAVES) {
        const float rs = 1.0f / sqrtf(a.ss2[m] * (1.0f / D) + NORM_EPS);
        float x[32], acc[32];
        const float* hrow = a.out + (size_t)m * D;
#pragma unroll
        for (int j = 0; j < 4; ++j) {
            const f32x4 h0 = *(const f32x4*)(hrow + j * 512 + lane * 8), h1 = *(const f32x4*)(hrow + j * 512 + lane * 8 + 4);
            const f32x4 g0 = *(const f32x4*)(a.g2 + j * 512 + lane * 8), g1 = *(const f32x4*)(a.g2 + j * 512 + lane * 8 + 4);
#pragma unroll
            for (int e = 0; e < 4; ++e) { x[j * 8 + e] = h0[e] * rs * g0[e]; x[j * 8 + 4 + e] = h1[e] * rs * g1[e]; acc[j * 8 + e] = 0.f; acc[j * 8 + 4 + e] = 0.f; }
        }
        const int e_lo = a.eidx[(size_t)m * 128 + lane], e_hi = a.eidx[(size_t)m * 128 + 64 + lane];
        const float g_lo = a.gates[(size_t)m * 128 + lane], g_hi = a.gates[(size_t)m * 128 + 64 + lane];
        for (int hh = 0; hh < 2; ++hh) {
            const int ev = hh ? e_hi : e_lo; const float gv = hh ? g_hi : g_lo;
            for (int q4 = 0; q4 < 16; ++q4) {
                int e[4]; float gt[4], dot[4];
#pragma unroll
                for (int c = 0; c < 4; ++c) { e[c] = __builtin_amdgcn_readlane(ev, q4 * 4 + c); gt[c] = __builtin_bit_cast(float, __builtin_amdgcn_readlane(__builtin_bit_cast(int, gv), q4 * 4 + c)); }
                u32x4 uw[4][4];
#pragma unroll
                for (int c = 0; c < 4; ++c)
#pragma unroll
                    for (int j = 0; j < 4; ++j) uw[c][j] = *(const u32x4*)(a.ub + (size_t)e[c] * D + j * 512 + lane * 8);
#pragma unroll
                for (int c = 0; c < 4; ++c) { float p = 0.f;
#pragma unroll
                    for (int j = 0; j < 4; ++j) {
                        p += bflo(uw[c][j].x) * x[j * 8 + 0] + bfhi(uw[c][j].x) * x[j * 8 + 1] + bflo(uw[c][j].y) * x[j * 8 + 2] + bfhi(uw[c][j].y) * x[j * 8 + 3];
                        p += bflo(uw[c][j].z) * x[j * 8 + 4] + bfhi(uw[c][j].z) * x[j * 8 + 5] + bflo(uw[c][j].w) * x[j * 8 + 6] + bfhi(uw[c][j].w) * x[j * 8 + 7]; }
                    dot[c] = wave_sum(p); }
#pragma unroll
                for (int c = 0; c < 4; ++c)
#pragma unroll
                    for (int j = 0; j < 4; ++j) uw[c][j] = *(const u32x4*)(a.vb + (size_t)e[c] * D + j * 512 + lane * 8);
#pragma unroll
                for (int c = 0; c < 4; ++c) { const float cf = gt[c] * gelu_tanh(dot[c]);
#pragma unroll
                    for (int j = 0; j < 4; ++j) {
                        acc[j * 8 + 0] += cf * bflo(uw[c][j].x); acc[j * 8 + 1] += cf * bfhi(uw[c][j].x); acc[j * 8 + 2] += cf * bflo(uw[c][j].y); acc[j * 8 + 3] += cf * bfhi(uw[c][j].y);
                        acc[j * 8 + 4] += cf * bflo(uw[c][j].z); acc[j * 8 + 5] += cf * bfhi(uw[c][j].z); acc[j * 8 + 6] += cf * bflo(uw[c][j].w); acc[j * 8 + 7] += cf * bfhi(uw[c][j].w); } }
            }
        }
        float ssq = 0.f;
#pragma unroll
        for (int j = 0; j < 4; ++j) {
            float* op = a.out + (size_t)m * D + j * 512 + lane * 8;
            const f32x4 h0 = *(const f32x4*)op, h1 = *(const f32x4*)(op + 4);
            f32x4 n0, n1;
#pragma unroll
            for (int e = 0; e < 4; ++e) { n0[e] = h0[e] + acc[j * 8 + e]; n1[e] = h1[e] + acc[j * 8 + 4 + e]; ssq += n0[e] * n0[e] + n1[e] * n1[e]; }
            *(f32x4*)op = n0; *(f32x4*)(op + 4) = n1;
            u32x4 wv; wv.x = pk2(n0[0], n0[1]); wv.y = pk2(n0[2], n0[3]); wv.z = pk2(n1[0], n1[1]); wv.w = pk2(n1[2], n1[3]);
            *(u32x4*)(a.hb + (size_t)m * D + j * 512 + lane * 8) = wv;
        }
        ssq = wave_sum(ssq);
        if (lane == 0) a.rs3[m] = 1.0f / sqrtf(ssq * (1.0f / D) + NORM_EPS);
    }
}

__device__ __forceinline__ void final_phase(float* out, const float* ss4, const float* gf, int G, int bid) {
    const int lane = threadIdx.x & 63, wave = threadIdx.x >> 6;
    for (int m = bid * NWAVES + wave; m < M; m += G * NWAVES) {
        const float rs = 1.0f / sqrtf(ss4[m] * (1.0f / D) + NORM_EPS);
        f32x4* r = (f32x4*)(out + (size_t)m * D) + lane; const f32x4* gp = (const f32x4*)gf + lane;
#pragma unroll
        for (int j = 0; j < 8; ++j) { f32x4 v = r[64 * j]; const f32x4 gg = gp[64 * j]; v = v * rs; v = v * gg; r[64 * j] = v; }
    }
}

constexpr int N_PHASES = 13;
#ifndef MK_N_LAUNCHES
#define MK_N_LAUNCHES 13
#endif
struct Args { const float* in[26]; float* out; unsigned char* ws; int ph_lo, ph_hi; };
__global__ void __launch_bounds__(NWAVES * 64, 2) mk_fwd(Args args) {
    extern __shared__ __attribute__((aligned(16))) unsigned char lds_raw[];
    LAS unsigned char* lds = (LAS unsigned char*)lds_raw;
    volatile LAS unsigned* MISC = (volatile LAS unsigned*)(lds + MISC_OFF);
    const int tid = threadIdx.x;
    const int G = gridDim.x, bid = blockIdx.x;
    unsigned char* ws = args.ws;
    gu32* ctl = (gu32*)(ws + WS_CTL);
    for (int u = tid; u < (LDS_BYTES - LDSCTL_OFF) / 4; u += NWAVES * 64) ((LAS unsigned*)(lds + LDSCTL_OFF))[u] = 0u;
    __syncthreads();
    XcdBarrier bar; bar.bar = (unsigned*)(ctl + CW_BAR); bar.x = 0; bar.st = nullptr;
    if (MK_N_LAUNCHES == 1) bar = xcd_barrier_post((unsigned*)(ctl + CW_BAR), MISC + 8);
    const int lo = args.ph_lo, hi = args.ph_hi;
#ifndef PHASE_MASK
#define PHASE_MASK 0xFFFFFFFFu
#endif
#define IN(k) (((PHASE_MASK >> (k)) & 1u) && lo <= (k) && (k) < hi)
#define SEAM(k) do { if (IN(k) && IN((k) + 1)) xcd_barrier(bar); } while (0)

    const float* x = args.in[0]; float* out = args.out;
    bf16_t* win_t = (bf16_t*)(ws + WS_WIN); bf16_t* wout_t = (bf16_t*)(ws + WS_WOUT); bf16_t* ws_t = (bf16_t*)(ws + WS_WS); bf16_t* wg_t = (bf16_t*)(ws + WS_WG);
    bf16_t* pup_t = (bf16_t*)(ws + WS_PUP); bf16_t* lora_t = (bf16_t*)(ws + WS_LORA); bf16_t* pb = (bf16_t*)(ws + WS_PB);
    bf16_t* xb = (bf16_t*)(ws + WS_XB); bf16_t* ymix = xb; bf16_t* pu = xb;
    bf16_t* zr = (bf16_t*)(ws + WS_ZR); bf16_t* law = zr; bf16_t* hb = zr;
    bf16_t* za = (bf16_t*)(ws + WS_ZA); bf16_t* ub = za; bf16_t* vb = (bf16_t*)(ws + WS_VB);
    bf16_t* zs = (bf16_t*)(ws + WS_ZS); float* sbuf = (float*)(ws + WS_S);
    int* eidx = (int*)(ws + WS_EIDX); float* gates = (float*)(ws + WS_GATES);
    float* ss2 = (float*)(ws + OFF_SS2); float* ss4 = (float*)(ws + OFF_SS4); float* rs1 = (float*)(ws + WS_RS1); float* rs3 = (float*)(ws + WS_RS3);

    if (IN(0)) {
        P0Args a{x, args.in[1], args.in[2], args.in[3], args.in[5], args.in[7], args.in[9], args.in[16], args.in[17], args.in[18], args.in[19], args.in[22], args.in[23], args.in[24],
                 win_t, wout_t, ws_t, wg_t, pup_t, lora_t, xb, pb, rs1};
        p0_prologue(lds, a, G, bid);
    }
    SEAM(0);
    if (IN(1)) {
        pg8::Gemm g{xb, win_t, M, INC, D, D}; pg8::StaticOrder S; S.init(M, INC, G, bid);
        EpiZ E{zr, za, rs1};
        pg8::gemm_phase<EpiZ, pg8::StaticOrder, true, true>(lds, g, S, E);
    }
    SEAM(1);
    if (IN(2)) p2_shift(zr, args.in[4], zs, G, bid);
    SEAM(2);
    if (IN(3)) {
        int kq = LORA_K; asm volatile("" : "+s"(kq));
        pg8::Gemm g{zs + 3072, lora_t, M, LORA_N, kq, RC}; pg8::StaticOrder S; S.init(M, LORA_N, G, bid);
        EpiLora E{law, args.in[6], args.in[8]};
        pg8::gemm_phase<EpiLora, pg8::StaticOrder, true, true>(lds, g, S, E);
    }
    SEAM(3);
    if (IN(4)) attn_phase(lds, za, args.in[15], ymix, G, bid);
    SEAM(4);
    if (IN(5)) { ScanArgs a{zs, law, args.in[10], args.in[11], args.in[12], args.in[13], args.in[14], ymix}; scan_phase(lds, a, G, bid); }
    SEAM(5);
    if (IN(6)) {
        cvt_stream(args.in[20], ub, (size_t)NEXP * D / 8, G, bid);
        cvt_stream(args.in[21], vb, (size_t)NEXP * D / 8, G, bid);
        pg8::Gemm g{ymix, wout_t, M, D, D, D}; pg8::StaticOrder S; S.init(M, D, G, bid);
        EpiRes1 E{x, out, hb, ss2};
        pg8::gemm_phase<EpiRes1, pg8::StaticOrder, true, true>(lds, g, S, E);
    }
    SEAM(6);
    if (IN(7)) {
        pg8::Gemm g{hb, ws_t, M, D, D, D}; pg8::StaticOrder S; S.init(M, D, G, bid);
        EpiS E{sbuf, ss2};
        pg8::gemm_phase<EpiS, pg8::StaticOrder, true, true>(lds, g, S, E);
    }
    SEAM(7);
    if (IN(8)) topk_phase(lds, sbuf, eidx, gates, G, bid);
    SEAM(8);
    if (IN(9)) { GatherArgs a{out, ss2, args.in[17], ub, vb, eidx, gates, hb, rs3}; gather_phase(a, G, bid); }
    SEAM(9);
    if (IN(10)) {
        int kq = PLE; asm volatile("" : "+s"(kq));
        pg8::Gemm g{pb, pup_t, M, D, kq, PLE}; pg8::StaticOrder S; S.init(M, D, G, bid);
        EpiBf E{pu, D};
        pg8::gemm_phase<EpiBf, pg8::StaticOrder, true, true>(lds, g, S, E);
    }
    SEAM(10);
    if (IN(11)) {
        pg8::Gemm g{hb, wg_t, M, D, D, D}; pg8::StaticOrder S; S.init(M, D, G, bid);
        EpiGate E{out, pu, rs3, ss4};
        pg8::gemm_phase<EpiGate, pg8::StaticOrder, true, true>(lds, g, S, E);
    }
    SEAM(11);
    if (IN(12)) final_phase(out, ss4, args.in[25], G, bid);
#undef IN
#undef SEAM
}

extern "C" void kernel_launch(void* const* d_in, const int* in_sizes, int n_in, void* d_out, int out_size, void* d_ws, size_t ws_size, hipStream_t stream) {
    static int grid = 0;
    if (grid == 0) {
        if (n_in != 26 || out_size != M * D || ws_size < WS_END) { fprintf(stderr, "kernel_launch: unexpected shapes n_in %d out %d ws %zu\n", n_in, out_size, ws_size); grid = -1; return; }
        int dev = 0, cus = 0;
        if (hipGetDevice(&dev) != hipSuccess || hipDeviceGetAttribute(&cus, hipDeviceAttributeMultiprocessorCount, dev) != hipSuccess) { grid = -1; return; }
        if (hipFuncSetAttribute((const void*)mk_fwd, hipFuncAttributeMaxDynamicSharedMemorySize, LDS_BYTES) != hipSuccess) { fprintf(stderr, "kernel_launch: hipFuncSetAttribute failed\n"); grid = -1; return; }
        int per_cu = 0;
        (void)hipOccupancyMaxActiveBlocksPerMultiprocessor(&per_cu, (const void*)mk_fwd, NWAVES * 64, LDS_BYTES);
        (void)hipGetLastError();
        grid = cus;
    }
    if (grid < 0) return;
    (void)hipMemsetAsync((char*)d_ws + WS_CTL, 0, CTL_ZERO_BYTES, stream);
    Args a{};
    for (int i = 0; i < 26; ++i) a.in[i] = (const float*)d_in[i];
    a.out = (float*)d_out; a.ws = (unsigned char*)d_ws;
    if (MK_N_LAUNCHES == 1) { a.ph_lo = 0; a.ph_hi = N_PHASES; hipLaunchKernelGGL(mk_fwd, dim3(grid), dim3(NWAVES * 64), LDS_BYTES, stream, a); }
    else for (int p = 0; p < N_PHASES; ++p) { a.ph_lo = p; a.ph_hi = p + 1; hipLaunchKernelGGL(mk_fwd, dim3(grid), dim3(NWAVES * 64), LDS_BYTES, stream, a); }
}
```

```cpp
#include <hip/hip_runtime.h>
#include <cstdio>
#include <cstdint>

#define GAS __attribute__((address_space(1)))
#define LAS __attribute__((address_space(3)))
#define PG8_LAS __attribute__((address_space(3)))
typedef unsigned short bf16_t;
typedef short bf16x8 __attribute__((ext_vector_type(8)));
typedef float f32x4 __attribute__((ext_vector_type(4)));
typedef float f32x2 __attribute__((ext_vector_type(2)));
typedef unsigned u32x4 __attribute__((ext_vector_type(4)));
typedef unsigned u32x2 __attribute__((ext_vector_type(2)));
typedef short s16x4 __attribute__((ext_vector_type(4)));

constexpr int BATCH = 2, T = 8192, D = 2048, M = BATCH * T;
constexpr int RW = 1024, AW = 1024, HD = 64, NH = 16;
constexpr int RC = 3328, INC = 6400, ACOLS = 3072;
constexpr int LORA_K = 256, LORA_N = 3072;
constexpr int PH = 8, NKEYS = 128, NEXP = 16384, TOPK = 16, PLE = 256;
constexpr float NORM_EPS = 1e-6f, LNX_EPS = 64e-5f;

namespace pg8 {
constexpr int BM = 256, BK = 64, HALF = 128, HTB = HALF * BK * 2  , STAGE_BYTES = 8 * HTB, NXCD = 8, WGM = 8;
__host__ __device__ __forceinline__ int lds_byte(int r, int c) { const int st = (r >> 4) * 2 + (c >> 5), rr = r & 15, cc = c & 31, ob = rr * 64 + cc * 2; return st * 1024 + (ob ^ (((ob >> 9) & 1) << 5)); }
__host__ __device__ __forceinline__ void stage_rc(int b, int& R, int& C) { const int st = b / 1024, sb = b % 1024, swz = sb ^ (((sb >> 9) & 1) << 5); R = (st >> 1) * 16 + swz / 64; C = (st & 1) * 32 + (swz % 64) / 2; }
__host__ __device__ __forceinline__ int perm32(int rho) { const int n = rho >> 4, i = rho & 15; return 8 * (i >> 2) + 4 * n + (i & 3); }

struct Unit { int pm, pn; };
struct Gemm { const bf16_t* A; const bf16_t* Bt; int M, N, K, lda; };

struct StaticOrder {
    int nM, nN, nwg, G, c;
    __host__ __device__ void init(int M, int N, int G_, int c_) { nM = M / BM; nN = N / BM; nwg = nM * nN; G = G_; c = c_; }
    __host__ __device__ bool next(int i, Unit& u) const {
        const long L = (long)i * G + c; if (L >= nwg) return false;
        int wgid = (int)L; { const int q = nwg / NXCD, r = nwg % NXCD, xcd = wgid % NXCD, off = wgid / NXCD; wgid = (xcd < r ? xcd * (q + 1) : r * (q + 1) + (xcd - r) * q) + off; }
        const int nig = WGM * nN, gid = wgid / nig, fm = gid * WGM, gsz = (nM - fm) < WGM ? (nM - fm) : WGM;
        u.pm = fm + ((wgid % nig) % gsz); u.pn = (wgid % nig) / gsz; return true;
    }
    __device__ __forceinline__ void a_ready(const Unit&) const {}
    __device__ __forceinline__ void done(const Unit&) const {}
};
__device__ __forceinline__ unsigned cvt_pk_bf16(float lo, float hi) { unsigned r; asm volatile("v_cvt_pk_bf16_f32 %0, %1, %2" : "=v"(r) : "v"(lo), "v"(hi)); return r; }

typedef int i32x4 __attribute__((ext_vector_type(4)));
template <class Epi, class Sched, bool ALIGN_EPI = false, bool SP2 = false, bool I8 = false>
__device__ __forceinline__ void gemm_phase(PG8_LAS unsigned char* lds, const Gemm g, const Sched& S, const Epi& E) {
    int tid = threadIdx.x; asm volatile("" : "+v"(tid));
    const int wid = __builtin_amdgcn_readfirstlane(tid >> 6), lane = tid & 63, wr = wid >> 2, wc = wid & 3, fr = lane & 15, fq = lane >> 4;
    const int K = g.K, nt = K / BK;
    unsigned voffA[2], voffB[2];
#pragma unroll
    for (int i = 0; i < 2; ++i) { int R, C; stage_rc(tid * 16 + i * 8192, R, C); const int Rb = Epi::PERM ? ((R & ~31) + perm32(R & 31)) : R;
        voffA[i] = (unsigned)(R * g.lda + C) * 2u; voffB[i] = (unsigned)(Rb * K + C) * 2u; }
    const size_t kstep = (size_t)(BK * 2);
    const size_t hstepA = (size_t)HALF * g.lda * 2, hstepB = (size_t)HALF * K * 2;
    const size_t tstepA = 2 * hstepA, tstepB = 2 * hstepB;
    const unsigned ldsw = (unsigned)wid * 1024u;
    const int aoff = lds_byte(wr * 64 + fr, fq * 8), boff = lds_byte(wc * 32 + fr, fq * 8);
#define PG8_SA(b, h) (((b) * 2 + (h)) * HTB)
#define PG8_SB(b, h) ((4 + (b) * 2 + (h)) * HTB)
#define PG8_STAGE(bufoff, gbase, voff) do { _Pragma("unroll") for (int _i = 0; _i < 2; ++_i) \
        __builtin_amdgcn_global_load_lds((const unsigned*)((const char*)(gbase) + (voff)[_i]), (PG8_LAS unsigned*)(lds + (bufoff) + ldsw + _i * 8192), 16, 0, 0); } while (0)
#define PG8_LDA(dst, b, h) do { _Pragma("unroll") for (int m = 0; m < 4; ++m) _Pragma("unroll") for (int k = 0; k < 2; ++k) dst[m][k] = *(const PG8_LAS bf16x8*)(lds + PG8_SA(b, h) + aoff + m * 2048 + k * 1024); } while (0)
#define PG8_LDB(dst, b, h) do { _Pragma("unroll") for (int n = 0; n < 2; ++n) _Pragma("unroll") for (int k = 0; k < 2; ++k) dst[n][k] = *(const PG8_LAS bf16x8*)(lds + PG8_SB(b, h) + boff + n * 2048 + k * 1024); } while (0)
#define PG8_MMA(ai, bj, At, Bt) do { __builtin_amdgcn_s_setprio(1); _Pragma("unroll") for (int m = 0; m < 4; ++m) _Pragma("unroll") for (int n = 0; n < 2; ++n) _Pragma("unroll") for (int k = 0; k < 2; ++k) \
        { if constexpr (I8) acc[ai][bj][m][n] = __builtin_bit_cast(f32x4, __builtin_amdgcn_mfma_i32_16x16x64_i8(__builtin_bit_cast(i32x4, Bt[n][k]), __builtin_bit_cast(i32x4, At[m][k]), __builtin_bit_cast(i32x4, acc[ai][bj][m][n]), 0, 0, 0)); \
          else acc[ai][bj][m][n] = __builtin_amdgcn_mfma_f32_16x16x32_bf16(Bt[n][k], At[m][k], acc[ai][bj][m][n], 0, 0, 0); } __builtin_amdgcn_s_setprio(0); } while (0)
#define PG8_WAIT_V(n) asm volatile("s_waitcnt vmcnt(" #n ")" ::: "memory")
#define PG8_WAIT_L(n) asm volatile("s_waitcnt lgkmcnt(" #n ")" ::: "memory")
#define PG8_BAR __builtin_amdgcn_s_barrier()
#define PG8_SCHED __builtin_amdgcn_sched_barrier(0)
    Unit cur, nxt; int ui = 0;
    if (!S.next(0, cur)) return;
    f32x4 acc[2][2][4][2];
#pragma unroll
    for (int a = 0; a < 2; ++a)
#pragma unroll
        for (int b = 0; b < 2; ++b)
#pragma unroll
            for (int m = 0; m < 4; ++m)
#pragma unroll
                for (int n = 0; n < 2; ++n) acc[a][b][m][n] = (f32x4){0.f, 0.f, 0.f, 0.f};
    bf16x8 At[4][2], B0[2][2], B1[2][2];
    const char* cA = (const char*)g.A + (size_t)cur.pm * tstepA; const char* cB = (const char*)g.Bt + (size_t)cur.pn * tstepB;
    S.a_ready(cur);
    if constexpr (SP2) {
        PG8_STAGE(PG8_SB(0, 0), cB, voffB); PG8_STAGE(PG8_SB(0, 1), cB + hstepB, voffB); PG8_STAGE(PG8_SA(0, 0), cA, voffA); PG8_STAGE(PG8_SA(0, 1), cA + hstepA, voffA);
        if (wr == 1) PG8_BAR;
        PG8_WAIT_V(2); PG8_BAR;
        PG8_STAGE(PG8_SB(1, 0), cB + kstep, voffB); PG8_STAGE(PG8_SA(1, 0), cA + kstep, voffA); PG8_STAGE(PG8_SB(1, 1), cB + hstepB + kstep, voffB);
        PG8_WAIT_V(6); PG8_BAR;
    } else {
        PG8_STAGE(PG8_SB(0, 0), cB, voffB); PG8_STAGE(PG8_SA(0, 0), cA, voffA); PG8_STAGE(PG8_SB(0, 1), cB + hstepB, voffB); PG8_STAGE(PG8_SA(0, 1), cA + hstepA, voffA);
        if (wr == 1) PG8_BAR;
        PG8_WAIT_V(4); PG8_BAR;
        PG8_STAGE(PG8_SB(1, 0), cB + kstep, voffB); PG8_STAGE(PG8_SA(1, 0), cA + kstep, voffA); PG8_STAGE(PG8_SB(1, 1), cB + hstepB + kstep, voffB);
        PG8_WAIT_V(6); PG8_BAR;
    }
    for (;;) {
        const bool has_next = S.next(ui + 1, nxt);
        const char* nA = has_next ? (const char*)g.A + (size_t)nxt.pm * tstepA : cA; const char* nB = has_next ? (const char*)g.Bt + (size_t)nxt.pn * tstepB : cB;
        for (int t = 0; t < nt; t += 2) {
            const bool last = (t == nt - 2);
            const char* a1 = cA + (size_t)(t + 1) * kstep;
            const char* a2 = last ? nA : cA + (size_t)(t + 2) * kstep; const char* b2 = last ? nB : cB + (size_t)(t + 2) * kstep;
            const char* a3 = a2 + kstep; const char* b3 = b2 + kstep;
            if (last && has_next) S.a_ready(nxt);
            if constexpr (SP2) {
            PG8_LDB(B0, 0, 0); PG8_LDB(B1, 0, 1); PG8_SCHED; PG8_LDA(At, 0, 0); PG8_STAGE(PG8_SA(1, 1), a1 + hstepA, voffA);
            PG8_WAIT_V(8); PG8_WAIT_L(0); PG8_BAR; PG8_MMA(0, 0, At, B0); PG8_MMA(0, 1, At, B1); PG8_BAR; PG8_SCHED;
            PG8_LDA(At, 0, 1); PG8_STAGE(PG8_SB(0, 0), b2, voffB); PG8_STAGE(PG8_SB(0, 1), b2 + hstepB, voffB); PG8_STAGE(PG8_SA(0, 0), a2, voffA);
            PG8_WAIT_V(8); PG8_WAIT_L(0); PG8_BAR; PG8_MMA(1, 0, At, B0); PG8_MMA(1, 1, At, B1); PG8_BAR; PG8_SCHED;
            PG8_LDB(B0, 1, 0); PG8_LDB(B1, 1, 1); PG8_SCHED; PG8_LDA(At, 1, 0); PG8_STAGE(PG8_SA(0, 1), a2 + hstepA, voffA);
            PG8_WAIT_V(8); PG8_WAIT_L(0); PG8_BAR; PG8_MMA(0, 0, At, B0); PG8_MMA(0, 1, At, B1); PG8_BAR; PG8_SCHED;
            PG8_LDA(At, 1, 1); PG8_STAGE(PG8_SB(1, 0), b3, voffB); PG8_STAGE(PG8_SB(1, 1), b3 + hstepB, voffB); PG8_STAGE(PG8_SA(1, 0), a3, voffA);
            PG8_WAIT_V(8); PG8_WAIT_L(0); PG8_BAR; PG8_MMA(1, 0, At, B0); PG8_MMA(1, 1, At, B1); PG8_BAR; PG8_SCHED;
            } else {
            PG8_LDB(B0, 0, 0); PG8_SCHED; PG8_LDA(At, 0, 0); PG8_STAGE(PG8_SA(1, 1), a1 + hstepA, voffA);
            PG8_WAIT_L(8); PG8_BAR; PG8_WAIT_L(0); PG8_MMA(0, 0, At, B0); PG8_BAR; PG8_SCHED;
            PG8_LDB(B1, 0, 1); PG8_STAGE(PG8_SB(0, 0), b2, voffB);
            PG8_BAR; PG8_WAIT_L(0); PG8_MMA(0, 1, At, B1); PG8_BAR;
            PG8_LDA(At, 0, 1); PG8_STAGE(PG8_SA(0, 0), a2, voffA);
            PG8_BAR; PG8_WAIT_L(0); PG8_MMA(1, 0, At, B0); PG8_BAR; PG8_SCHED;
            PG8_STAGE(PG8_SB(0, 1), b2 + hstepB, voffB);
            PG8_WAIT_V(6); PG8_BAR; PG8_MMA(1, 1, At, B1); PG8_BAR;
            PG8_LDB(B0, 1, 0); PG8_SCHED; PG8_LDA(At, 1, 0); PG8_STAGE(PG8_SA(0, 1), a2 + hstepA, voffA);
            PG8_WAIT_L(8); PG8_BAR; PG8_WAIT_L(0); PG8_MMA(0, 0, At, B0); PG8_BAR; PG8_SCHED;
            PG8_LDB(B1, 1, 1); PG8_STAGE(PG8_SB(1, 0), b3, voffB);
            PG8_BAR; PG8_WAIT_L(0); PG8_MMA(0, 1, At, B1); PG8_BAR;
            PG8_LDA(At, 1, 1); PG8_STAGE(PG8_SA(1, 0), a3, voffA);
            PG8_BAR; PG8_WAIT_L(0); PG8_MMA(1, 0, At, B0); PG8_BAR; PG8_SCHED;
            PG8_STAGE(PG8_SB(1, 1), b3 + hstepB, voffB);
            PG8_WAIT_V(6); PG8_BAR; PG8_MMA(1, 1, At, B1); PG8_BAR;
            }
        }
        if constexpr (ALIGN_EPI) { if (wr == 0) PG8_BAR; }
        if constexpr (I8) {
#pragma unroll
            for (int a_ = 0; a_ < 2; ++a_)
#pragma unroll
                for (int b_ = 0; b_ < 2; ++b_)
#pragma unroll
                    for (int m_ = 0; m_ < 4; ++m_)
#pragma unroll
                        for (int n_ = 0; n_ < 2; ++n_) { const i32x4 iv = __builtin_bit_cast(i32x4, acc[a_][b_][m_][n_]); acc[a_][b_][m_][n_] = (f32x4){(float)iv[0], (float)iv[1], (float)iv[2], (float)iv[3]}; }
        }
        if constexpr (!Epi::AFTER_DRAIN) { E(acc, cur, wr, wc, fr, fq); S.done(cur); }
        if (!has_next) break;
#pragma unroll
        for (int a = 0; a < 2; ++a)
#pragma unroll
            for (int b = 0; b < 2; ++b)
#pragma unroll
                for (int m = 0; m < 4; ++m)
#pragma unroll
                    for (int n = 0; n < 2; ++n) acc[a][b][m][n] = (f32x4){0.f, 0.f, 0.f, 0.f};
        cur = nxt; cA = nA; cB = nB; ++ui;
        if constexpr (ALIGN_EPI) { if (wr == 1) PG8_BAR; }
    }
    PG8_WAIT_V(0);
    if constexpr (!ALIGN_EPI) { if (wr == 0) PG8_BAR; }
    PG8_BAR;
    if constexpr (Epi::AFTER_DRAIN) { E.fused(acc, cur, wr, wc, fr, fq, lds, wid, lane); S.done(cur); }
#undef PG8_SA
#undef PG8_SB
#undef PG8_STAGE
#undef PG8_LDA
#undef PG8_LDB
#undef PG8_MMA
#undef PG8_WAIT_V
#undef PG8_WAIT_L
#undef PG8_BAR
#undef PG8_SCHED
}
}

constexpr size_t MiB = 1u << 20;
constexpr size_t WS_CTL = 0, CTL_ZERO_BYTES = 1 * MiB;
constexpr size_t OFF_SS2 = 256 * 1024, OFF_SS4 = 320 * 1024;
constexpr size_t OFF_CM_IN = 448 * 1024, OFF_CM_G = 480 * 1024;
constexpr size_t WS_RS1 = 1 * MiB, WS_RS3 = 1 * MiB + 64 * 1024;
constexpr size_t WS_WIN = 2 * MiB, WS_WOUT = 27 * MiB, WS_WS = 35 * MiB, WS_WG = 43 * MiB, WS_PUP = 51 * MiB, WS_LORA = 52 * MiB, WS_PB = 54 * MiB;
constexpr size_t WS_ALORA = 2 * MiB;
constexpr size_t WS_XB = 62 * MiB;
constexpr size_t WS_ZR = 126 * MiB;
constexpr size_t WS_S = 190 * MiB;
constexpr size_t WS_ZA = 230 * MiB;
constexpr size_t WS_UQ = 326 * MiB, WS_VQ = 358 * MiB;
constexpr size_t WS_LAW = 390 * MiB;
constexpr size_t WS_EIDX = 390 * MiB, WS_GATES = 398 * MiB;
constexpr size_t WS_YH = 454 * MiB, WS_BONUS = 486 * MiB;
constexpr size_t WS_END = 512 * MiB;
constexpr int CW_BAR = 4096;

constexpr int NWAVES = 8;
constexpr int RING_BYTES = 131072;
constexpr int LDSCTL_OFF = RING_BYTES, MISC_OFF = LDSCTL_OFF + 320;
constexpr int LDS_BYTES = 147456;

typedef GAS unsigned gu32;
#define RLX_AGENT __ATOMIC_RELAXED, __HIP_MEMORY_SCOPE_AGENT
#define LDS_WAIT() asm volatile("s_waitcnt lgkmcnt(0)" ::: "memory")
#define VM_WAIT() asm volatile("s_waitcnt vmcnt(0)" ::: "memory")
#define LBAR() do { asm volatile("s_waitcnt lgkmcnt(0)" ::: "memory"); __builtin_amdgcn_s_barrier(); asm volatile("" ::: "memory"); } while (0)
__device__ __forceinline__ unsigned f2bf(float f) { unsigned u = __builtin_bit_cast(unsigned, f); return (u + 0x7fffu + ((u >> 16) & 1u)) >> 16; }
__device__ __forceinline__ unsigned pk2(float lo, float hi) { return f2bf(lo) | (f2bf(hi) << 16); }
__device__ __forceinline__ float bflo(unsigned w) { return __builtin_bit_cast(float, w << 16); }
__device__ __forceinline__ float bfhi(unsigned w) { return __builtin_bit_cast(float, w & 0xffff0000u); }
__device__ __forceinline__ float wave_sum(float v) {
#pragma unroll
    for (int o = 1; o < 64; o <<= 1) v += __shfl_xor(v, o);
    return v;
}
__device__ __forceinline__ float sigmoidf_(float x) { return 1.0f / (1.0f + __expf(-x)); }

#define XB_TMO      128
#define XB_XCNT(j)  (256  + 64 * (j))
#define XB_XSUB(j)  (1280 + 64 * (j))
#define XB_XGEN(j)  (2304 + 64 * (j))
#define XB_TOP      3328
#define XB_TOPGEN   3392
#define XCD_BAR_WORDS 3456
#define XB_SPIN_CAP (1u << 18)

__device__ __forceinline__ unsigned xb_ld(unsigned* p)              { return __hip_atomic_load(p, __ATOMIC_RELAXED, __HIP_MEMORY_SCOPE_AGENT); }
__device__ __forceinline__ unsigned xb_add(unsigned* p, unsigned v) { return __hip_atomic_fetch_add(p, v, __ATOMIC_RELAXED, __HIP_MEMORY_SCOPE_AGENT); }
__device__ __forceinline__ unsigned xb_xcc_id() { return (unsigned)__builtin_amdgcn_s_getreg((3 << 11) | 20) & 0xFu; }
#define XB_SPIN(cond, bar) do { unsigned _sp = 0; while (cond) { __builtin_amdgcn_s_sleep(1); \
    if ((++_sp & 255u) == 0u) { if (xb_ld(&(bar)[XB_TMO])) break; if (_sp > XB_SPIN_CAP) { atomicAdd(&(bar)[XB_TMO], 1u); break; } } } } while (0)

struct XcdBarrier {
    unsigned* bar; unsigned x;
    volatile LAS unsigned* st;
};

__device__ __forceinline__ XcdBarrier xcd_barrier_post(unsigned* bar, volatile LAS unsigned* st) {
    XcdBarrier b; b.bar = bar; b.x = xb_xcc_id(); b.st = st;
    if (threadIdx.x == 0) (void)xb_add(&bar[XB_XCNT(b.x)], 1u);
    return b;
}
__device__ __forceinline__ void xcd_barrier_complete(unsigned* bar, unsigned x, unsigned& nloc, unsigned& nx) {
    const unsigned G = gridDim.x * gridDim.y * gridDim.z;
    unsigned sum, cnt, mine, sp = 0u;
    for (;;) {
        sum = 0u; cnt = 0u; mine = 0u;
#pragma unroll
        for (unsigned j = 0; j < 16; ++j) { const unsigned c = xb_ld(&bar[XB_XCNT(j)]); sum += c; cnt += (c > 0u) ? 1u : 0u; mine = (j == x) ? c : mine; }
        if (sum == G) break;
        __builtin_amdgcn_s_sleep(1);
        if ((++sp & 255u) == 0u) { if (xb_ld(&bar[XB_TMO])) break; if (sp > XB_SPIN_CAP) { atomicAdd(&bar[XB_TMO], 1u); break; } }
    }
    nloc = mine > 0u ? mine : 1u; nx = cnt > 0u ? cnt : 1u;
}

__device__ __forceinline__ void xcd_barrier(const XcdBarrier& b) {
    asm volatile("s_waitcnt vmcnt(0)" ::: "memory");
    __syncthreads();
    if (threadIdx.x == 0) {
        unsigned* bar = b.bar;
        __builtin_amdgcn_s_waitcnt(0);
        unsigned nloc = b.st[0], nx = b.st[1];
        if (nloc == 0u) { xcd_barrier_complete(bar, b.x, nloc, nx); b.st[0] = nloc; b.st[1] = nx; }
        const unsigned old = xb_add(&bar[XB_XSUB(b.x)], 1u);
        const unsigned gen = old / nloc;
        if (old + 1u == (gen + 1u) * nloc) {
            __builtin_amdgcn_fence(__ATOMIC_RELEASE, "agent");
            asm volatile("s_waitcnt vmcnt(0)" ::: "memory");
            const unsigned og = xb_add(&bar[XB_TOP], 1u);
            const unsigned tg = og / nx;
            if (og + 1u == (tg + 1u) * nx) xb_add(&bar[XB_TOPGEN], 1u);
            else XB_SPIN(xb_ld(&bar[XB_TOPGEN]) == tg, bar);
            __builtin_amdgcn_fence(__ATOMIC_ACQUIRE, "agent");
            xb_add(&bar[XB_XGEN(b.x)], 1u);
            asm volatile("s_waitcnt vmcnt(0)" ::: "memory");
        } else {
            XB_SPIN(xb_ld(&bar[XB_XGEN(b.x)]) == gen, bar);
            __builtin_amdgcn_fence(__ATOMIC_ACQUIRE, "agent");
            asm volatile("s_waitcnt vmcnt(0)" ::: "memory");
        }
    }
    __syncthreads();
}


__device__ __forceinline__ void p0_transpose_item(const float* W, int K, int N, bf16_t* WT, const float* ksc, LAS float* scr, int item, int lane) {
    const int nblk = N / 32, kb = item / nblk, nb = item % nblk, k0 = 64 * kb, n0 = 32 * nb;
#pragma unroll 8
    for (int i = 0; i < 32; ++i) { const int kk = 2 * i + (lane >> 5); const float sc = ksc ? ksc[k0 + kk] : 1.0f; scr[kk * 33 + (lane & 31)] = W[(size_t)(k0 + kk) * N + n0 + (lane & 31)] * sc; }
    LDS_WAIT(); asm volatile("" ::: "memory");
    const int c = lane & 7;
#pragma unroll
    for (int j = 0; j < 4; ++j) { const int n = (lane >> 3) + 8 * j; const LAS float* s = scr + (8 * c) * 33 + n;
        u32x4 o; o.x = pk2(s[0 * 33], s[1 * 33]); o.y = pk2(s[2 * 33], s[3 * 33]); o.z = pk2(s[4 * 33], s[5 * 33]); o.w = pk2(s[6 * 33], s[7 * 33]);
        *(u32x4*)(WT + (size_t)(n0 + n) * K + k0 + 8 * c) = o; }
    LDS_WAIT(); asm volatile("" ::: "memory");
}

__device__ __forceinline__ void p0_qtranspose_item(const float* W, int K, int N, unsigned char* WT, const float* ksc, const float* cmax, LAS float* scr, int item, int lane) {
    const int nblk = N / 32, kb = item / nblk, nb = item % nblk, k0 = 64 * kb, n0 = 32 * nb;
#pragma unroll 8
    for (int i = 0; i < 32; ++i) { const int kk = 2 * i + (lane >> 5); scr[kk * 33 + (lane & 31)] = W[(size_t)(k0 + kk) * N + n0 + (lane & 31)] * ksc[k0 + kk]; }
    LDS_WAIT(); asm volatile("" ::: "memory");
    const int c = lane & 7;
#pragma unroll
    for (int j = 0; j < 4; ++j) { const int n = (lane >> 3) + 8 * j; const LAS float* sp = scr + (8 * c) * 33 + n;
        const float inv = 127.0f / fmaxf(cmax[n0 + n], 1e-30f);
        u32x2 o;
        o.x = ((unsigned)__float2int_rn(sp[0 * 33] * inv) & 0xffu) | (((unsigned)__float2int_rn(sp[1 * 33] * inv) & 0xffu) << 8) | (((unsigned)__float2int_rn(sp[2 * 33] * inv) & 0xffu) << 16) | ((unsigned)__float2int_rn(sp[3 * 33] * inv) << 24);
        o.y = ((unsigned)__float2int_rn(sp[4 * 33] * inv) & 0xffu) | (((unsigned)__float2int_rn(sp[5 * 33] * inv) & 0xffu) << 8) | (((unsigned)__float2int_rn(sp[6 * 33] * inv) & 0xffu) << 16) | ((unsigned)__float2int_rn(sp[7 * 33] * inv) << 24);
        *(u32x2*)(WT + (size_t)(n0 + n) * K + k0 + 8 * c) = o; }
    LDS_WAIT(); asm volatile("" ::: "memory");
}
__device__ __forceinline__ void p0_colmax(const float* W, int K, int N, const float* ksc, float* cmax, int gt, int NGT) {
    constexpr int KSEG = 32;
    for (int idx = gt; idx < N * (K / KSEG); idx += NGT) {
        const int n = idx % N, ks = idx / N; float mx = 0.f;
        for (int k = ks * KSEG; k < (ks + 1) * KSEG; ++k) mx = fmaxf(mx, fabsf(W[(size_t)k * N + n] * ksc[k]));
        atomicMax((int*)cmax + n, __float_as_int(mx));
    }
}
struct P0Args { const float *x, *p, *g1, *w_in, *decay_up, *iclr_up, *gate_up, *w_out, *g2, *wq, *sk, *g3, *wg, *ple_up;
                bf16_t *win_t, *wout_t, *ws_t, *wg_t, *pup_t, *lora_t, *xb, *pb; float* rs1; float* cm_in; float* cm_g; };

template <int PART> __device__ __forceinline__ void p0_prologue(LAS unsigned char* lds, const P0Args& a, int G, int bid) {
    const int tid = threadIdx.x, lane = tid & 63, wave = __builtin_amdgcn_readfirstlane(tid >> 6);
    const int gw = bid * NWAVES + wave, NGW = G * NWAVES;
    const int gt = bid * 512 + tid, NGT = G * 512;
    if (PART == 1) {
        LAS float* skl = (LAS float*)lds; LAS float* wql = (LAS float*)(lds + 128 * 129 * 4);
        for (int item = bid; item < 512; item += G) {
            const int hi = item >> 5, k0 = (item & 31) * 64;
            __syncthreads();
            for (int idx = tid; idx < 128 * 128; idx += 512) { const int n = idx >> 7, d = idx & 127; skl[n * 129 + d] = a.sk[(size_t)hi * 16384 + idx]; }
            for (int idx = tid; idx < 64 * 128; idx += 512) { const int k = idx >> 7, d = idx & 127; wql[d * 65 + k] = a.wq[(size_t)(k0 + k) * 2048 + hi * 128 + d]; }
            __syncthreads();
            const int n = tid & 127, kq = tid >> 7;
            float acc[16];
#pragma unroll
            for (int j = 0; j < 16; ++j) acc[j] = 0.f;
            for (int d = 0; d < 128; ++d) { const float s = skl[n * 129 + d];
#pragma unroll
                for (int j = 0; j < 16; ++j) acc[j] += s * wql[d * 65 + kq * 16 + j]; }
            bf16_t* o = a.ws_t + (size_t)(hi * 128 + n) * 2048 + k0 + kq * 16;
            const float* gg = a.g2 + k0 + kq * 16;
            u32x4 o0, o1;
            o0.x = pk2(acc[0] * gg[0], acc[1] * gg[1]); o0.y = pk2(acc[2] * gg[2], acc[3] * gg[3]); o0.z = pk2(acc[4] * gg[4], acc[5] * gg[5]); o0.w = pk2(acc[6] * gg[6], acc[7] * gg[7]);
            o1.x = pk2(acc[8] * gg[8], acc[9] * gg[9]); o1.y = pk2(acc[10] * gg[10], acc[11] * gg[11]); o1.z = pk2(acc[12] * gg[12], acc[13] * gg[13]); o1.w = pk2(acc[14] * gg[14], acc[15] * gg[15]);
            *(u32x4*)o = o0; *(u32x4*)(o + 8) = o1;
        }
        __syncthreads();
    }
    {
        LAS float* scr = (LAS float*)(lds + wave * 16384);
        constexpr int I_IN = (D / 64) * (INC / 32), I_SQ = (D / 64) * (D / 32), I_PU = (PLE / 64) * (D / 32);
        constexpr int NITEMS = I_IN + 2 * I_SQ + I_PU;
        if (PART == 0) { p0_colmax(a.w_in, D, INC, a.g1, a.cm_in, gt, NGT); p0_colmax(a.wg, D, D, a.g3, a.cm_g, gt, NGT); }
        if (PART != 0) for (int it = (PART == 2 ? 0 : I_IN) + gw; it < (PART == 2 ? I_IN : NITEMS); it += NGW) {
            int r = it;
            if (r < I_IN) { p0_qtranspose_item(a.w_in, D, INC, (unsigned char*)a.win_t, a.g1, a.cm_in, scr, r, lane); continue; } r -= I_IN;
            if (r < I_SQ) { p0_transpose_item(a.w_out, D, D, a.wout_t, nullptr, scr, r, lane); continue; } r -= I_SQ;
            if (r < I_SQ) { p0_qtranspose_item(a.wg, D, D, (unsigned char*)a.wg_t, a.g3, a.cm_g, scr, r, lane); continue; } r -= I_SQ;
            p0_transpose_item(a.ple_up, PLE, D, a.pup_t, nullptr, scr, r, lane);
        }
    }
    if (PART == 0) for (int idx = gt; idx < LORA_N * LORA_K; idx += NGT) {
        const int n = idx >> 8, k = idx & 255; float v = 0.f;
        if (n < 1024) { if (k < 64) v = a.decay_up[k * 1024 + n]; }
        else if (n < 2048) { if (k >= 64 && k < 128) v = a.iclr_up[(k - 64) * 1024 + (n - 1024)]; }
        else { if (k >= 128) v = a.gate_up[(k - 128) * 1024 + (n - 2048)]; }
        a.lora_t[idx] = (bf16_t)f2bf(v);
    }
    if (PART == 0) for (int m = gw; m < M; m += NGW) {
        const f32x4* xr = (const f32x4*)(a.x + (size_t)m * D) + lane;
        f32x4 v[8]; float sq = 0.f, mx = 0.f;
#pragma unroll
        for (int j = 0; j < 8; ++j) { v[j] = xr[64 * j]; sq += (v[j].x * v[j].x + v[j].y * v[j].y) + (v[j].z * v[j].z + v[j].w * v[j].w); mx = fmaxf(mx, fmaxf(fmaxf(fabsf(v[j].x), fabsf(v[j].y)), fmaxf(fabsf(v[j].z), fabsf(v[j].w)))); }
        sq = wave_sum(sq);
#pragma unroll
        for (int o = 1; o < 64; o <<= 1) mx = fmaxf(mx, __shfl_xor(mx, o));
        const float step = fmaxf(mx, 1e-30f) * (1.0f / 127.0f), inv = 1.0f / step;
        if (lane == 0) a.rs1[m] = step / sqrtf(sq * (1.0f / D) + NORM_EPS);
        unsigned* o4 = (unsigned*)((unsigned char*)a.xb + (size_t)m * D) + lane;
#pragma unroll
        for (int j = 0; j < 8; ++j) o4[64 * j] = ((unsigned)__float2int_rn(v[j].x * inv) & 0xffu) | (((unsigned)__float2int_rn(v[j].y * inv) & 0xffu) << 8) | (((unsigned)__float2int_rn(v[j].z * inv) & 0xffu) << 16) | ((unsigned)__float2int_rn(v[j].w * inv) << 24);
    }
    if (PART == 1) for (int idx = gt; idx < M * PLE / 8; idx += NGT) {
        const f32x4 v0 = *((const f32x4*)a.p + 2 * (size_t)idx), v1 = *((const f32x4*)a.p + 2 * (size_t)idx + 1);
        u32x4 o; o.x = pk2(v0.x, v0.y); o.y = pk2(v0.z, v0.w); o.z = pk2(v1.x, v1.y); o.w = pk2(v1.z, v1.w);
        *((u32x4*)a.pb + idx) = o;
    }
}

__device__ __forceinline__ void cvt_stream(const float* src, bf16_t* dst, size_t n8, int G, int bid) {
    for (size_t idx = (size_t)bid * 512 + threadIdx.x; idx < n8; idx += (size_t)G * 512) {
        const f32x4 v0 = *((const f32x4*)src + 2 * idx), v1 = *((const f32x4*)src + 2 * idx + 1);
        u32x4 o; o.x = pk2(v0.x, v0.y); o.y = pk2(v0.z, v0.w); o.z = pk2(v1.x, v1.y); o.w = pk2(v1.z, v1.w);
        *((u32x4*)dst + idx) = o;
    }
}


template <bool SIGNED> __device__ __forceinline__ void quant_rows(const float* src, unsigned char* dst, float* scale, int G, int bid) {
    const int lane = threadIdx.x & 63, wave = __builtin_amdgcn_readfirstlane(threadIdx.x >> 6);
    for (int e = bid * NWAVES + wave; e < NEXP; e += G * NWAVES) {
        const f32x4* r = (const f32x4*)(src + (size_t)e * D);
        f32x4 v[8]; float mx = 0.f;
#pragma unroll
        for (int j = 0; j < 2; ++j)
#pragma unroll
            for (int q = 0; q < 4; ++q) { const f32x4 t = r[j * 256 + lane * 4 + q]; v[j * 4 + q] = t; mx = fmaxf(mx, fmaxf(fmaxf(fabsf(t[0]), fabsf(t[1])), fmaxf(fabsf(t[2]), fabsf(t[3])))); }
#pragma unroll
        for (int o = 1; o < 64; o <<= 1) mx = fmaxf(mx, __shfl_xor(mx, o));
        const float sc = fmaxf(mx, 1e-30f) * (1.0f / 127.0f), inv = 1.0f / sc;
        if (lane == 0) scale[e] = sc;
#pragma unroll
        for (int j = 0; j < 2; ++j) {
            u32x4 o;
#pragma unroll
            for (int q = 0; q < 4; ++q) { const f32x4 t = v[j * 4 + q];
                constexpr int OFFS = SIGNED ? 0 : 128;
                const unsigned b0 = (unsigned)(__float2int_rn(t[0] * inv) + OFFS) & 0xffu, b1 = (unsigned)(__float2int_rn(t[1] * inv) + OFFS) & 0xffu, b2 = (unsigned)(__float2int_rn(t[2] * inv) + OFFS) & 0xffu, b3 = (unsigned)(__float2int_rn(t[3] * inv) + OFFS) & 0xffu;
                o[q] = b0 | (b1 << 8) | (b2 << 16) | (b3 << 24); }
            *(u32x4*)(dst + (size_t)e * D + j * 1024 + lane * 16) = o;
        }
    }
}

__device__ __forceinline__ void p2_alora(const bf16_t* zr, const float* mu, bf16_t* alora, int G, int bid) {
    for (int idx = bid * 512 + threadIdx.x; idx < M * 32; idx += G * 512) {
        const int m = idx >> 5, c8 = idx & 31, t = m & (T - 1), col = 3072 + c8 * 8;
        const u32x4 cur = *(const u32x4*)(zr + (size_t)m * RC + col);
        u32x4 prv = (u32x4){0u, 0u, 0u, 0u};
        if (t > 0) prv = *(const u32x4*)(zr + (size_t)(m - 1) * RC + col);
        const f32x4 mu0 = *(const f32x4*)(mu + col), mu1 = *(const f32x4*)(mu + col + 4);
        float z[8], zp[8], mm[8] = {mu0.x, mu0.y, mu0.z, mu0.w, mu1.x, mu1.y, mu1.z, mu1.w};
        z[0] = bflo(cur.x); z[1] = bfhi(cur.x); z[2] = bflo(cur.y); z[3] = bfhi(cur.y); z[4] = bflo(cur.z); z[5] = bfhi(cur.z); z[6] = bflo(cur.w); z[7] = bfhi(cur.w);
        zp[0] = bflo(prv.x); zp[1] = bfhi(prv.x); zp[2] = bflo(prv.y); zp[3] = bfhi(prv.y); zp[4] = bflo(prv.z); zp[5] = bfhi(prv.z); zp[6] = bflo(prv.w); zp[7] = bfhi(prv.w);
#pragma unroll
        for (int j = 0; j < 8; ++j) { float v = z[j] + (zp[j] - z[j]) * mm[j];
            if (c8 < 8) v = tanhf(v); else if (c8 >= 16) v = sigmoidf_(v);
            z[j] = v; }
        u32x4 o; o.x = pk2(z[0], z[1]); o.y = pk2(z[2], z[3]); o.z = pk2(z[4], z[5]); o.w = pk2(z[6], z[7]);
        *(u32x4*)(alora + (size_t)m * LORA_K + c8 * 8) = o;
    }
}

#define EPI_LOOP_BEGIN \
    _Pragma("unroll") for (int ai = 0; ai < 2; ++ai) _Pragma("unroll") for (int m = 0; m < 4; ++m) { const int row = u.pm * 256 + ai * 128 + wr * 64 + m * 16 + fr; \
    _Pragma("unroll") for (int bj = 0; bj < 2; ++bj) { const int ct = bj * 128 + wc * 32 + 8 * fq; const f32x4 v0 = acc[ai][bj][m][0], v1 = acc[ai][bj][m][1];
#define EPI_LOOP_END } }

struct EpiZ {
    static constexpr bool PERM = true, AFTER_DRAIN = false;
    bf16_t* zr; bf16_t* za; const float* rs1; const float* cmax;
    __device__ __forceinline__ void operator()(const f32x4 (&acc)[2][2][4][2], const pg8::Unit& u, int wr, int wc, int fr, int fq) const {
        bf16_t* base; int ld, c0;
        if (u.pn < 13) { base = zr; ld = RC; c0 = u.pn * 256; } else { base = za; ld = ACOLS; c0 = (u.pn - 13) * 256; }
        EPI_LOOP_BEGIN
            const float sc = rs1[row] * (1.0f / 127.0f);
            const f32x4 c0v = *(const f32x4*)(cmax + u.pn * 256 + ct), c1v = *(const f32x4*)(cmax + u.pn * 256 + ct + 4);
            u32x4 w; w.x = pg8::cvt_pk_bf16(v0[0] * sc * c0v[0], v0[1] * sc * c0v[1]); w.y = pg8::cvt_pk_bf16(v0[2] * sc * c0v[2], v0[3] * sc * c0v[3]); w.z = pg8::cvt_pk_bf16(v1[0] * sc * c1v[0], v1[1] * sc * c1v[1]); w.w = pg8::cvt_pk_bf16(v1[2] * sc * c1v[2], v1[3] * sc * c1v[3]);
            *(u32x4*)(base + (size_t)row * ld + c0 + ct) = w;
        EPI_LOOP_END
    }
};
struct EpiLora {
    static constexpr bool PERM = true, AFTER_DRAIN = false;
    bf16_t* law; bf16_t* gdst; const float* w0; const float* a0;
    __device__ __forceinline__ void operator()(const f32x4 (&acc)[2][2][4][2], const pg8::Unit& u, int wr, int wc, int fr, int fq) const {
        const int kind = u.pn >> 2;
        EPI_LOOP_BEGIN
            const int c = u.pn * 256 + ct;
            float v[8] = {v0[0], v0[1], v0[2], v0[3], v1[0], v1[1], v1[2], v1[3]};
            if (kind == 0) {
#pragma unroll
                for (int j = 0; j < 8; ++j) v[j] = -0.6065306597126334f * sigmoidf_(w0[c + j] + v[j]);
            } else if (kind == 1) {
#pragma unroll
                for (int j = 0; j < 8; ++j) v[j] = sigmoidf_(a0[c - 1024 + j] + v[j]);
            }
            u32x4 w; w.x = pg8::cvt_pk_bf16(v[0], v[1]); w.y = pg8::cvt_pk_bf16(v[2], v[3]); w.z = pg8::cvt_pk_bf16(v[4], v[5]); w.w = pg8::cvt_pk_bf16(v[6], v[7]);
            if (kind < 2) *(u32x4*)(law + (size_t)row * 2048 + c) = w; else *(u32x4*)(gdst + (size_t)row * D + (c - 2048)) = w;
        EPI_LOOP_END
    }
};
struct EpiRes1 {
    static constexpr bool PERM = true, AFTER_DRAIN = false;
    const float* x; bf16_t* hb; float* ss;
    __device__ __forceinline__ void operator()(const f32x4 (&acc)[2][2][4][2], const pg8::Unit& u, int wr, int wc, int fr, int fq) const {
        float part[2][4];
#pragma unroll
        for (int i = 0; i < 2; ++i)
#pragma unroll
            for (int j = 0; j < 4; ++j) part[i][j] = 0.f;
        EPI_LOOP_BEGIN
            const size_t o = (size_t)row * D + u.pn * 256 + ct;
            const f32x4 x0 = *(const f32x4*)(x + o), x1 = *(const f32x4*)(x + o + 4);
            const f32x4 h0 = x0 + v0, h1 = x1 + v1;
            u32x4 w; w.x = pg8::cvt_pk_bf16(h0[0], h0[1]); w.y = pg8::cvt_pk_bf16(h0[2], h0[3]); w.z = pg8::cvt_pk_bf16(h1[0], h1[1]); w.w = pg8::cvt_pk_bf16(h1[2], h1[3]);
            *(u32x4*)(hb + o) = w;
            part[ai][m] += (h0[0] * h0[0] + h0[1] * h0[1]) + (h0[2] * h0[2] + h0[3] * h0[3]) + (h1[0] * h1[0] + h1[1] * h1[1]) + (h1[2] * h1[2] + h1[3] * h1[3]);
        EPI_LOOP_END
#pragma unroll
        for (int ai = 0; ai < 2; ++ai)
#pragma unroll
            for (int m = 0; m < 4; ++m) { float p = part[ai][m]; p += __shfl_xor(p, 16); p += __shfl_xor(p, 32);
                if (fq == 0) atomicAdd(ss + u.pm * 256 + ai * 128 + wr * 64 + m * 16 + fr, p); }
    }
};
struct EpiS {
    static constexpr bool PERM = true, AFTER_DRAIN = false;
    float* s; const float* ss;
    __device__ __forceinline__ void operator()(const f32x4 (&acc)[2][2][4][2], const pg8::Unit& u, int wr, int wc, int fr, int fq) const {
        EPI_LOOP_BEGIN
            const float sc = 1.0f / sqrtf(ss[row] * (1.0f / D) + NORM_EPS);
            const size_t o = (size_t)row * D + u.pn * 256 + ct;
            *(f32x4*)(s + o) = v0 * sc; *(f32x4*)(s + o + 4) = v1 * sc;
        EPI_LOOP_END
    }
};
struct EpiBf {
    static constexpr bool PERM = true, AFTER_DRAIN = false;
    bf16_t* o; int ldc;
    __device__ __forceinline__ void operator()(const f32x4 (&acc)[2][2][4][2], const pg8::Unit& u, int wr, int wc, int fr, int fq) const {
        EPI_LOOP_BEGIN
            u32x4 w; w.x = pg8::cvt_pk_bf16(v0[0], v0[1]); w.y = pg8::cvt_pk_bf16(v0[2], v0[3]); w.z = pg8::cvt_pk_bf16(v1[0], v1[1]); w.w = pg8::cvt_pk_bf16(v1[2], v1[3]);
            *(u32x4*)(o + (size_t)row * ldc + u.pn * 256 + ct) = w;
        EPI_LOOP_END
    }
};
struct EpiGate {
    static constexpr bool PERM = true, AFTER_DRAIN = false;
    const bf16_t* h2; bf16_t* pu; const float* rs3; float* ss; const float* cmax;
    __device__ __forceinline__ void operator()(const f32x4 (&acc)[2][2][4][2], const pg8::Unit& u, int wr, int wc, int fr, int fq) const {
        float part[2][4];
#pragma unroll
        for (int i = 0; i < 2; ++i)
#pragma unroll
            for (int j = 0; j < 4; ++j) part[i][j] = 0.f;
        EPI_LOOP_BEGIN
            const size_t o = (size_t)row * D + u.pn * 256 + ct;
            const float sc = rs3[row] * (1.0f / 127.0f);
            const f32x4 c0v = *(const f32x4*)(cmax + u.pn * 256 + ct) * sc, c1v = *(const f32x4*)(cmax + u.pn * 256 + ct + 4) * sc;
            const u32x4 hw = *(const u32x4*)(h2 + o);
            const f32x4 a0 = {bflo(hw.x), bfhi(hw.x), bflo(hw.y), bfhi(hw.y)}, a1 = {bflo(hw.z), bfhi(hw.z), bflo(hw.w), bfhi(hw.w)};
            const u32x4 pw = *(const u32x4*)(pu + o);
            f32x4 h0, h1;
            h0[0] = a0[0] + sigmoidf_(v0[0] * c0v[0]) * bflo(pw.x); h0[1] = a0[1] + sigmoidf_(v0[1] * c0v[1]) * bfhi(pw.x);
            h0[2] = a0[2] + sigmoidf_(v0[2] * c0v[2]) * bflo(pw.y); h0[3] = a0[3] + sigmoidf_(v0[3] * c0v[3]) * bfhi(pw.y);
            h1[0] = a1[0] + sigmoidf_(v1[0] * c1v[0]) * bflo(pw.z); h1[1] = a1[1] + sigmoidf_(v1[1] * c1v[1]) * bfhi(pw.z);
            h1[2] = a1[2] + sigmoidf_(v1[2] * c1v[2]) * bflo(pw.w); h1[3] = a1[3] + sigmoidf_(v1[3] * c1v[3]) * bfhi(pw.w);
            { u32x4 w3; w3.x = pg8::cvt_pk_bf16(h0[0], h0[1]); w3.y = pg8::cvt_pk_bf16(h0[2], h0[3]); w3.z = pg8::cvt_pk_bf16(h1[0], h1[1]); w3.w = pg8::cvt_pk_bf16(h1[2], h1[3]); *(u32x4*)(pu + o) = w3; }
            part[ai][m] += (h0[0] * h0[0] + h0[1] * h0[1]) + (h0[2] * h0[2] + h0[3] * h0[3]) + (h1[0] * h1[0] + h1[1] * h1[1]) + (h1[2] * h1[2] + h1[3] * h1[3]);
        EPI_LOOP_END
#pragma unroll
        for (int ai = 0; ai < 2; ++ai)
#pragma unroll
            for (int m = 0; m < 4; ++m) { float p = part[ai][m]; p += __shfl_xor(p, 16); p += __shfl_xor(p, 32);
                if (fq == 0) atomicAdd(ss + u.pm * 256 + ai * 128 + wr * 64 + m * 16 + fr, p); }
    }
};

typedef short v4i16_t __attribute__((ext_vector_type(4)));
__device__ __forceinline__ s16x4 vtr(const LAS unsigned char* p) { return __builtin_bit_cast(s16x4, __builtin_amdgcn_ds_read_tr16_b64_v4i16((LAS v4i16_t*)p)); }
constexpr int VROW = 144, ATT_SLOT = 64 * VROW;
__device__ __forceinline__ float xmax4(float v) {
    auto a = __builtin_amdgcn_permlane16_swap(__float_as_uint(v), __float_as_uint(v), false, false); v = fmaxf(__uint_as_float(a[0]), __uint_as_float(a[1]));
    auto b = __builtin_amdgcn_permlane32_swap(__float_as_uint(v), __float_as_uint(v), false, false); return fmaxf(__uint_as_float(b[0]), __uint_as_float(b[1]));
}
__device__ __forceinline__ float xsum4(float v) {
    auto a = __builtin_amdgcn_permlane16_swap(__float_as_uint(v), __float_as_uint(v), false, false); v = __uint_as_float(a[0]) + __uint_as_float(a[1]);
    auto b = __builtin_amdgcn_permlane32_swap(__float_as_uint(v), __float_as_uint(v), false, false); return __uint_as_float(b[0]) + __uint_as_float(b[1]);
}
struct AttnW { const LAS float* biasl; int g, i, ql; float bias_far; };
__device__ __forceinline__ void attn_tile2(const LAS unsigned char* kl, const LAS unsigned char* vl, const bf16x8 (&qf)[2][2], const AttnW& c, int delta, float (&m_run)[2], float (&l)[2], f32x4 (&o)[2][4]) {
    constexpr float SC = 0.125f * 1.4426950408889634f;
    f32x4 s[2][4];
    const LAS unsigned char* kb = kl + c.i * VROW + c.g * 16;
#pragma unroll
    for (int t = 0; t < 4; ++t) {
        const bf16x8 k0 = *(const LAS bf16x8*)(kb + t * 16 * VROW), k1 = *(const LAS bf16x8*)(kb + t * 16 * VROW + 64);
#pragma unroll
        for (int q = 0; q < 2; ++q) {
            s[q][t] = __builtin_amdgcn_mfma_f32_16x16x32_bf16(k0, qf[q][0], (f32x4){0.f, 0.f, 0.f, 0.f}, 0, 0, 0);
            s[q][t] = __builtin_amdgcn_mfma_f32_16x16x32_bf16(k1, qf[q][1], s[q][t], 0, 0, 0);
        }
    }
    bf16x8 pb[2][2];
#pragma unroll
    for (int q = 0; q < 2; ++q) {
        float mx = -INFINITY;
        if (delta >= 3) {
#pragma unroll
            for (int t = 0; t < 4; ++t)
#pragma unroll
                for (int r = 0; r < 4; ++r) { const float v = s[q][t][r] * SC + c.bias_far; s[q][t][r] = v; mx = fmaxf(mx, v); }
        } else {
            const int base = 64 * delta + c.ql + 16 * q + c.i - 4 * c.g;
#pragma unroll
            for (int t = 0; t < 4; ++t)
#pragma unroll
                for (int r = 0; r < 4; ++r) { int dd = base - (16 * t + r); dd = dd > 128 ? 128 : dd; const float v = s[q][t][r] * SC + c.biasl[128 + dd]; s[q][t][r] = v; mx = fmaxf(mx, v); }
        }
        mx = xmax4(mx);
        const float m_new = (mx > m_run[q] + 6.0f) ? mx : m_run[q];
        if (__builtin_amdgcn_ballot_w64(m_new != m_run[q]) != 0ull) {
            const float f = __builtin_amdgcn_exp2f(m_run[q] - m_new);
            l[q] *= f;
#pragma unroll
            for (int dt = 0; dt < 4; ++dt) o[q][dt] = o[q][dt] * f;
        }
        float ps = 0.f;
#pragma unroll
        for (int t = 0; t < 4; ++t)
#pragma unroll
            for (int r = 0; r < 4; ++r) { const float pv = __builtin_amdgcn_exp2f(s[q][t][r] - m_new); s[q][t][r] = pv; ps += pv; }
        l[q] += ps; m_run[q] = m_new;
#pragma unroll
        for (int ks = 0; ks < 2; ++ks) {
            u32x4 wv; wv.x = pg8::cvt_pk_bf16(s[q][2 * ks][0], s[q][2 * ks][1]); wv.y = pg8::cvt_pk_bf16(s[q][2 * ks][2], s[q][2 * ks][3]); wv.z = pg8::cvt_pk_bf16(s[q][2 * ks + 1][0], s[q][2 * ks + 1][1]); wv.w = pg8::cvt_pk_bf16(s[q][2 * ks + 1][2], s[q][2 * ks + 1][3]);
            pb[q][ks] = __builtin_bit_cast(bf16x8, wv);
        }
    }
    const LAS unsigned char* vb = vl + (4 * c.g + (c.i >> 2)) * VROW + 8 * (c.i & 3);
#pragma unroll
    for (int dt = 0; dt < 4; ++dt)
#pragma unroll
        for (int ks = 0; ks < 2; ++ks) {
            const LAS unsigned char* p0 = vb + 32 * ks * VROW + 32 * dt;
            const s16x4 lo = vtr(p0), hi = vtr(p0 + 16 * VROW);
            const bf16x8 af = (bf16x8){lo[0], lo[1], lo[2], lo[3], hi[0], hi[1], hi[2], hi[3]};
            o[0][dt] = __builtin_amdgcn_mfma_f32_16x16x32_bf16(af, pb[0][ks], o[0][dt], 0, 0, 0);
            o[1][dt] = __builtin_amdgcn_mfma_f32_16x16x32_bf16(af, pb[1][ks], o[1][dt], 0, 0, 0);
        }
}
__device__ __forceinline__ void attn_phase(LAS unsigned char* lds, const bf16_t* za, const float* rel_bias, bf16_t* ymix, int G, int bid) {
    const int tid = threadIdx.x, lane = tid & 63, w = __builtin_amdgcn_readfirstlane(tid >> 6), g = lane >> 4, i = lane & 15;
    LAS unsigned char* kring = lds; LAS unsigned char* vring = lds + 3 * ATT_SLOT;
    LAS float* biasl = (LAS float*)(lds + 6 * ATT_SLOT);
    const int skey = tid >> 3, sch = tid & 7;
    const int soff = skey * VROW + sch * 16;
    constexpr int NUNIT = BATCH * NH * 32;
    const int upb = (NUNIT + G - 1) / G;
    for (int unit = bid * upb; unit < (bid + 1) * upb && unit < NUNIT; ++unit) {
        const int bh = unit >> 5, cq = unit & 31, b = bh >> 4, h = bh & 15, c0 = 4 * cq;
        const int jt0 = c0 - 8 < 0 ? 0 : c0 - 8, ntile = c0 + 4 - jt0;
        const bf16_t* zb = za + (size_t)b * T * ACOLS + h * 64;
        const bf16_t* sp = zb + (size_t)(jt0 * 64 + skey) * ACOLS + sch * 8;
        constexpr size_t TSTEP = (size_t)64 * ACOLS;
        __syncthreads();
        if (tid < 257) biasl[tid] = rel_bias[h * 257 + tid] * 1.4426950408889634f;
        u32x4 kr0, vr0, kr1, vr1, kr2, vr2;
        kr0 = *(const u32x4*)(sp + 1024); vr0 = *(const u32x4*)(sp + 2048);
        kr1 = *(const u32x4*)(sp + TSTEP + 1024); vr1 = *(const u32x4*)(sp + TSTEP + 2048);
        kr2 = *(const u32x4*)(sp + 2 * TSTEP + 1024); vr2 = *(const u32x4*)(sp + 2 * TSTEP + 2048);
        const int cw = c0 + (w >> 1);
        AttnW c; c.biasl = biasl; c.g = g; c.i = i; c.ql = (w & 1) * 32;
        bf16x8 qf[2][2];
#pragma unroll
        for (int q = 0; q < 2; ++q) { const size_t tq = (size_t)(cw * 64 + c.ql + 16 * q + i); qf[q][0] = *(const bf16x8*)(zb + tq * ACOLS + g * 8); qf[q][1] = *(const bf16x8*)(zb + tq * ACOLS + 32 + g * 8); }
        *(LAS u32x4*)(kring + soff) = kr0; *(LAS u32x4*)(vring + soff) = vr0;
        float m_run[2] = {-INFINITY, -INFINITY}, l[2] = {0.f, 0.f};
        f32x4 o[2][4];
#pragma unroll
        for (int q = 0; q < 2; ++q)
#pragma unroll
            for (int dt = 0; dt < 4; ++dt) o[q][dt] = (f32x4){0.f, 0.f, 0.f, 0.f};
#define ATT_IT(n, KI, VI, KW, VW, SR, SW) do { \
            LBAR(); \
            if ((n) == 0) c.bias_far = biasl[256]; \
            if ((n) + 3 < ntile) { KI = *(const u32x4*)(sp + (size_t)((n) + 3) * TSTEP + 1024); VI = *(const u32x4*)(sp + (size_t)((n) + 3) * TSTEP + 2048); } \
            { const int jt = jt0 + (n); if (jt >= cw - 8 && jt <= cw) attn_tile2(kring + (SR) * ATT_SLOT, vring + (SR) * ATT_SLOT, qf, c, cw - jt, m_run, l, o); } \
            if ((n) + 1 < ntile) { *(LAS u32x4*)(kring + (SW) * ATT_SLOT + soff) = KW; *(LAS u32x4*)(vring + (SW) * ATT_SLOT + soff) = VW; } } while (0)
        for (int n = 0; n < ntile; n += 3) {
            ATT_IT(n, kr0, vr0, kr1, vr1, 0, 1);
            if (n + 1 < ntile) ATT_IT(n + 1, kr1, vr1, kr2, vr2, 1, 2);
            if (n + 2 < ntile) ATT_IT(n + 2, kr2, vr2, kr0, vr0, 2, 0);
        }
#undef ATT_IT
#pragma unroll
        for (int q = 0; q < 2; ++q) {
            const float il = 1.0f / xsum4(l[q]);
            bf16_t* orow = ymix + ((size_t)b * T + cw * 64 + c.ql + 16 * q + i) * D + 1024 + h * 64;
#pragma unroll
            for (int dt = 0; dt < 4; ++dt) { u32x2 wv; wv.x = pg8::cvt_pk_bf16(o[q][dt][0] * il, o[q][dt][1] * il); wv.y = pg8::cvt_pk_bf16(o[q][dt][2] * il, o[q][dt][3] * il); *(u32x2*)(orow + 16 * dt + 4 * g) = wv; }
        }
    }
}

#define DPPF(v, ctrl) __int_as_float(__builtin_amdgcn_update_dpp(0, __float_as_int(v), (ctrl), 0xF, 0xF, true))
__device__ __forceinline__ float dpp_sum8(float v) {
    v += DPPF(v, 0xB1);
    v += DPPF(v, 0x4E);
    v += DPPF(v, 0x141);
    return v;
}
__device__ __forceinline__ float wave_sum_dpp(float v) {
    v += DPPF(v, 0xB1); v += DPPF(v, 0x4E); v += DPPF(v, 0x141); v += DPPF(v, 0x140);
    v += __int_as_float(__builtin_amdgcn_update_dpp(0, __float_as_int(v), 0x142, 0xA, 0xF, false));
    v += __int_as_float(__builtin_amdgcn_update_dpp(0, __float_as_int(v), 0x143, 0xC, 0xF, false));
    return __int_as_float(__builtin_amdgcn_readlane(__float_as_int(v), 63));
}
constexpr int CL = 64, MROW = 144, MSZ = 64 * MROW;
__device__ __forceinline__ bf16x8 frag_row(const LAS unsigned char* img, int row0, int k0, int g, int i) { return *(const LAS bf16x8*)(img + (row0 + i) * MROW + (k0 + 8 * g) * 2); }
__device__ __forceinline__ bf16x8 frag_col(const LAS unsigned char* img, int k0, int col0, int g, int i) {
    const LAS unsigned char* p = img + (k0 + 8 * g + (i >> 2)) * MROW + (col0 + 4 * (i & 3)) * 2;
    const s16x4 lo = vtr(p), hi = vtr(p + 4 * MROW);
    return (bf16x8){lo[0], lo[1], lo[2], lo[3], hi[0], hi[1], hi[2], hi[3]};
}
#define MFMA16(a, b, c) __builtin_amdgcn_mfma_f32_16x16x32_bf16((a), (b), (c), 0, 0, 0)
typedef __bf16 bf16x2_t __attribute__((ext_vector_type(2)));
__device__ __forceinline__ unsigned cvtpk_c(float lo, float hi) { const f32x2 v = {lo, hi}; const bf16x2_t b = __builtin_convertvector(v, bf16x2_t); return __builtin_bit_cast(unsigned, b); }
__device__ __forceinline__ void st_bf16x4(LAS unsigned char* img, int x, int y, const f32x4& v) { u32x2 w; w.x = cvtpk_c(v[0], v[1]); w.y = cvtpk_c(v[2], v[3]); *(LAS u32x2*)(img + x * MROW + y * 2) = w; }

struct ScanArgs { const bf16_t* zr; const bf16_t* law; const float* mu; const float *k_k, *k_a, *r_k, *lnx_g, *lnx_b; bf16_t* ymix; float* pq; };
struct ChunkOut { LAS unsigned char* pm; LAS unsigned char* qm; };
constexpr int L_NT = 0, L_RT = MSZ, L_BH = 2 * MSZ, L_KH = 3 * MSZ, L_BB = 4 * MSZ, L_KB = 5 * MSZ, L_VV = 6 * MSZ, L_ANK = 7 * MSZ, L_ARB = 8 * MSZ, L_ARK = 9 * MSZ;
constexpr int L_ANB = 10 * MSZ;
constexpr int L_TOT = L_ANB + 16384;
constexpr int L_DG = L_TOT + 8 * 64 * 4 + 256;
constexpr int L_END = L_DG + 2048;
constexpr int L_TM = L_BH, L_X1 = L_KH, L_WH = L_ANK, L_NH = L_ANB;


#ifndef SCAN_DEBUG
#define SCAN_DEBUG 0
#endif
constexpr int DBG_WORD = 2048;
__device__ __forceinline__ float img_at(const LAS unsigned char* img, int r, int c) { return bflo((unsigned)*(const LAS bf16_t*)(img + r * MROW + c * 2)); }
__device__ __forceinline__ void dbg_flag(unsigned* dbg, bool bad, unsigned bit) { if (bad) atomicOr(dbg, bit); }
__device__ __forceinline__ bool dbg_bad(float got, float ref) { return !(fabsf(got - ref) <= 0.03f * fabsf(ref) + 0.02f); }
__device__ __forceinline__ void fchain(int n, float& c, const f32x4& a, float t0, float t1, float t2, float t3) {
    const float a0 = a[0], a1 = a[1], a2 = a[2], a3 = a[3];
    if (n == 1) asm("v_fma_f32 %0, %1, %2, %0" : "+v"(c) : "v"(a0), "v"(t0));
    else if (n == 2) asm("v_fma_f32 %0, %1, %2, %0\n\tv_fma_f32 %0, %3, %4, %0" : "+v"(c) : "v"(a0), "v"(t0), "v"(a1), "v"(t1));
    else if (n == 3) asm("v_fma_f32 %0, %1, %2, %0\n\tv_fma_f32 %0, %3, %4, %0\n\tv_fma_f32 %0, %5, %6, %0" : "+v"(c) : "v"(a0), "v"(t0), "v"(a1), "v"(t1), "v"(a2), "v"(t2));
    else asm("v_fma_f32 %0, %1, %2, %0\n\tv_fma_f32 %0, %3, %4, %0\n\tv_fma_f32 %0, %5, %6, %0\n\tv_fma_f32 %0, %7, %8, %0" : "+v"(c) : "v"(a0), "v"(t0), "v"(a1), "v"(t1), "v"(a2), "v"(t2), "v"(a3), "v"(t3));
}
__device__ __forceinline__ float mchain(int n, const f32x4& a, float t0, float t1, float t2, float t3) {
    const float a0 = a[0], a1 = a[1], a2 = a[2], a3 = a[3]; float c;
    if (n == 1) asm("v_mul_f32 %0, %1, %2" : "=&v"(c) : "v"(a0), "v"(t0));
    else if (n == 2) asm("v_mul_f32 %0, %1, %2\n\tv_fma_f32 %0, %3, %4, %0" : "=&v"(c) : "v"(a0), "v"(t0), "v"(a1), "v"(t1));
    else if (n == 3) asm("v_mul_f32 %0, %1, %2\n\tv_fma_f32 %0, %3, %4, %0\n\tv_fma_f32 %0, %5, %6, %0" : "=&v"(c) : "v"(a0), "v"(t0), "v"(a1), "v"(t1), "v"(a2), "v"(t2));
    else asm("v_mul_f32 %0, %1, %2\n\tv_fma_f32 %0, %3, %4, %0\n\tv_fma_f32 %0, %5, %6, %0\n\tv_fma_f32 %0, %7, %8, %0" : "=&v"(c) : "v"(a0), "v"(t0), "v"(a1), "v"(t1), "v"(a2), "v"(t2), "v"(a3), "v"(t3));
    return c;
}
__device__ __forceinline__ void oct_fma8(float (&x)[8], float a0, float a1, float a2, float a3, float a4, float a5, float a6, float a7, float t) {
    asm("v_fma_f32 %0, %8, %16, %0\n\tv_fma_f32 %1, %9, %16, %1\n\tv_fma_f32 %2, %10, %16, %2\n\tv_fma_f32 %3, %11, %16, %3\n\tv_fma_f32 %4, %12, %16, %4\n\tv_fma_f32 %5, %13, %16, %5\n\tv_fma_f32 %6, %14, %16, %6\n\tv_fma_f32 %7, %15, %16, %7"
        : "+v"(x[0]), "+v"(x[1]), "+v"(x[2]), "+v"(x[3]), "+v"(x[4]), "+v"(x[5]), "+v"(x[6]), "+v"(x[7])
        : "v"(a0), "v"(a1), "v"(a2), "v"(a3), "v"(a4), "v"(a5), "v"(a6), "v"(a7), "v"(t));
}
__device__ __forceinline__ void oct_mul8(float (&x)[8], float a0, float a1, float a2, float a3, float a4, float a5, float a6, float a7, float t) {
    asm("v_mul_f32 %0, %8, %16\n\tv_mul_f32 %1, %9, %16\n\tv_mul_f32 %2, %10, %16\n\tv_mul_f32 %3, %11, %16\n\tv_mul_f32 %4, %12, %16\n\tv_mul_f32 %5, %13, %16\n\tv_mul_f32 %6, %14, %16\n\tv_mul_f32 %7, %15, %16"
        : "=&v"(x[0]), "=&v"(x[1]), "=&v"(x[2]), "=&v"(x[3]), "=&v"(x[4]), "=&v"(x[5]), "=&v"(x[6]), "=&v"(x[7])
        : "v"(a0), "v"(a1), "v"(a2), "v"(a3), "v"(a4), "v"(a5), "v"(a6), "v"(a7), "v"(t));
}
__device__ __forceinline__ void oct_dpp_sum8(float (&x)[8]) {
    asm("s_nop 1\n\tv_add_f32_dpp %0, %0, %0 quad_perm:[1,0,3,2] row_mask:0xf bank_mask:0xf bound_ctrl:1\n\tv_add_f32_dpp %1, %1, %1 quad_perm:[1,0,3,2] row_mask:0xf bank_mask:0xf bound_ctrl:1\n\tv_add_f32_dpp %2, %2, %2 quad_perm:[1,0,3,2] row_mask:0xf bank_mask:0xf bound_ctrl:1\n\tv_add_f32_dpp %3, %3, %3 quad_perm:[1,0,3,2] row_mask:0xf bank_mask:0xf bound_ctrl:1\n\tv_add_f32_dpp %4, %4, %4 quad_perm:[1,0,3,2] row_mask:0xf bank_mask:0xf bound_ctrl:1\n\tv_add_f32_dpp %5, %5, %5 quad_perm:[1,0,3,2] row_mask:0xf bank_mask:0xf bound_ctrl:1\n\tv_add_f32_dpp %6, %6, %6 quad_perm:[1,0,3,2] row_mask:0xf bank_mask:0xf bound_ctrl:1\n\tv_add_f32_dpp %7, %7, %7 quad_perm:[1,0,3,2] row_mask:0xf bank_mask:0xf bound_ctrl:1\n\tv_add_f32_dpp %0, %0, %0 quad_perm:[2,3,0,1] row_mask:0xf bank_mask:0xf bound_ctrl:1\n\tv_add_f32_dpp %1, %1, %1 quad_perm:[2,3,0,1] row_mask:0xf bank_mask:0xf bound_ctrl:1\n\tv_add_f32_dpp %2, %2, %2 quad_perm:[2,3,0,1] row_mask:0xf bank_mask:0xf bound_ctrl:1\n\tv_add_f32_dpp %3, %3, %3 quad_perm:[2,3,0,1] row_mask:0xf bank_mask:0xf bound_ctrl:1\n\tv_add_f32_dpp %4, %4, %4 quad_perm:[2,3,0,1] row_mask:0xf bank_mask:0xf bound_ctrl:1\n\tv_add_f32_dpp %5, %5, %5 quad_perm:[2,3,0,1] row_mask:0xf bank_mask:0xf bound_ctrl:1\n\tv_add_f32_dpp %6, %6, %6 quad_perm:[2,3,0,1] row_mask:0xf bank_mask:0xf bound_ctrl:1\n\tv_add_f32_dpp %7, %7, %7 quad_perm:[2,3,0,1] row_mask:0xf bank_mask:0xf bound_ctrl:1\n\tv_add_f32_dpp %0, %0, %0 row_half_mirror row_mask:0xf bank_mask:0xf bound_ctrl:1\n\tv_add_f32_dpp %1, %1, %1 row_half_mirror row_mask:0xf bank_mask:0xf bound_ctrl:1\n\tv_add_f32_dpp %2, %2, %2 row_half_mirror row_mask:0xf bank_mask:0xf bound_ctrl:1\n\tv_add_f32_dpp %3, %3, %3 row_half_mirror row_mask:0xf bank_mask:0xf bound_ctrl:1\n\tv_add_f32_dpp %4, %4, %4 row_half_mirror row_mask:0xf bank_mask:0xf bound_ctrl:1\n\tv_add_f32_dpp %5, %5, %5 row_half_mirror row_mask:0xf bank_mask:0xf bound_ctrl:1\n\tv_add_f32_dpp %6, %6, %6 row_half_mirror row_mask:0xf bank_mask:0xf bound_ctrl:1\n\tv_add_f32_dpp %7, %7, %7 row_half_mirror row_mask:0xf bank_mask:0xf bound_ctrl:1"
        : "+v"(x[0]), "+v"(x[1]), "+v"(x[2]), "+v"(x[3]), "+v"(x[4]), "+v"(x[5]), "+v"(x[6]), "+v"(x[7]));
}
__device__ __forceinline__ void oct_col(int n, float& y0, float& y1, float& y2, float& y3, float& y4, float& y5, float& y6, float l0, float l1, float l2, float l3, float l4, float l5, float l6, float xp) {
    if (n == 7) asm("v_fma_f32 %0, %7, %14, %0\n\tv_fma_f32 %1, %8, %14, %1\n\tv_fma_f32 %2, %9, %14, %2\n\tv_fma_f32 %3, %10, %14, %3\n\tv_fma_f32 %4, %11, %14, %4\n\tv_fma_f32 %5, %12, %14, %5\n\tv_fma_f32 %6, %13, %14, %6" : "+v"(y0), "+v"(y1), "+v"(y2), "+v"(y3), "+v"(y4), "+v"(y5), "+v"(y6) : "v"(l0), "v"(l1), "v"(l2), "v"(l3), "v"(l4), "v"(l5), "v"(l6), "v"(xp));
    else if (n == 6) asm("v_fma_f32 %0, %6, %12, %0\n\tv_fma_f32 %1, %7, %12, %1\n\tv_fma_f32 %2, %8, %12, %2\n\tv_fma_f32 %3, %9, %12, %3\n\tv_fma_f32 %4, %10, %12, %4\n\tv_fma_f32 %5, %11, %12, %5" : "+v"(y0), "+v"(y1), "+v"(y2), "+v"(y3), "+v"(y4), "+v"(y5) : "v"(l0), "v"(l1), "v"(l2), "v"(l3), "v"(l4), "v"(l5), "v"(xp));
    else if (n == 5) asm("v_fma_f32 %0, %5, %10, %0\n\tv_fma_f32 %1, %6, %10, %1\n\tv_fma_f32 %2, %7, %10, %2\n\tv_fma_f32 %3, %8, %10, %3\n\tv_fma_f32 %4, %9, %10, %4" : "+v"(y0), "+v"(y1), "+v"(y2), "+v"(y3), "+v"(y4) : "v"(l0), "v"(l1), "v"(l2), "v"(l3), "v"(l4), "v"(xp));
    else if (n == 4) asm("v_fma_f32 %0, %4, %8, %0\n\tv_fma_f32 %1, %5, %8, %1\n\tv_fma_f32 %2, %6, %8, %2\n\tv_fma_f32 %3, %7, %8, %3" : "+v"(y0), "+v"(y1), "+v"(y2), "+v"(y3) : "v"(l0), "v"(l1), "v"(l2), "v"(l3), "v"(xp));
    else if (n == 3) asm("v_fma_f32 %0, %3, %6, %0\n\tv_fma_f32 %1, %4, %6, %1\n\tv_fma_f32 %2, %5, %6, %2" : "+v"(y0), "+v"(y1), "+v"(y2) : "v"(l0), "v"(l1), "v"(l2), "v"(xp));
    else if (n == 2) asm("v_fma_f32 %0, %2, %4, %0\n\tv_fma_f32 %1, %3, %4, %1" : "+v"(y0), "+v"(y1) : "v"(l0), "v"(l1), "v"(xp));
    else if (n == 1) asm("v_fma_f32 %0, %1, %2, %0" : "+v"(y0) : "v"(l0), "v"(xp));
}
struct ChunkRaw { bf16_t r[9], k[9], v[9], lw[8], a[8]; };
__device__ __forceinline__ void chunk_load(ChunkRaw& q, const ScanArgs& a, size_t m0, int h) {
    const int lane = threadIdx.x & 63, w = __builtin_amdgcn_readfirstlane(threadIdx.x >> 6);
    const size_t mb = m0 + 8 * w;
    const bool first = ((mb & (T - 1)) == 0);
    const bf16_t* zp = a.zr + (first ? mb : mb - 1) * RC + h * 64 + lane;
    q.r[0] = first ? (bf16_t)0 : zp[0]; q.k[0] = first ? (bf16_t)0 : zp[1024]; q.v[0] = first ? (bf16_t)0 : zp[2048];
#pragma unroll
    for (int e = 0; e < 8; ++e) { const size_t m = mb + e; const bf16_t* z = a.zr + m * RC + h * 64 + lane;
        q.r[e + 1] = z[0]; q.k[e + 1] = z[1024]; q.v[e + 1] = z[2048];
        q.lw[e] = a.law[m * 2048 + h * 64 + lane]; q.a[e] = a.law[m * 2048 + 1024 + h * 64 + lane]; }
}
__device__ __forceinline__ void chunk_build(LAS unsigned char* lds, const ScanArgs& a, const ChunkRaw& raw, int h, float* bonus_out, unsigned* dbg) {
    const int tid = threadIdx.x, lane = tid & 63, w = __builtin_amdgcn_readfirstlane(tid >> 6), g = lane >> 4, i = lane & 15;
    LAS float* tot = (LAS float*)(lds + L_TOT);
#ifndef SA_PROBE
#define SA_PROBE 0
#endif
    for (int rep_ = 0; rep_ < (SA_PROBE == 1 ? 2 : 1); ++rep_) {
        if (rep_) __syncthreads();
        const float kkc = a.k_k[h * 64 + lane], kac = a.k_a[h * 64 + lane], rkc = a.r_k[h * 64 + lane];
        const float mur = a.mu[h * 64 + lane], muk = a.mu[1024 + h * 64 + lane], muv = a.mu[2048 + h * 64 + lane];
        float r[8], kp[8], vv[8], nn[8], bb[8], lw[8], bo8[8];
#pragma unroll
        for (int e = 0; e < 8; ++e) {
            const float rc = bflo((unsigned)raw.r[e + 1]), kc = bflo((unsigned)raw.k[e + 1]), vc = bflo((unsigned)raw.v[e + 1]);
            r[e] = rc + (bflo((unsigned)raw.r[e]) - rc) * mur; const float k = kc + (bflo((unsigned)raw.k[e]) - kc) * muk; vv[e] = vc + (bflo((unsigned)raw.v[e]) - vc) * muv;
            lw[e] = bflo((unsigned)raw.lw[e]); const float aa = bflo((unsigned)raw.a[e]);
            const float kkr = k * kkc; const float ss = wave_sum_dpp(kkr * kkr);
            const float kk = kkr * __builtin_amdgcn_rcpf(fmaxf(sqrtf(ss), 1e-12f));
            kp[e] = k * (1.0f + (aa - 1.0f) * kac); nn[e] = -kk; bb[e] = kk * aa;
            bo8[e] = wave_sum_dpp(r[e] * kp[e] * rkc);
        }
        if (bonus_out && lane == 0) {
            *(f32x4*)(bonus_out + 8 * w) = (f32x4){bo8[0], bo8[1], bo8[2], bo8[3]}; *(f32x4*)(bonus_out + 8 * w + 4) = (f32x4){bo8[4], bo8[5], bo8[6], bo8[7]};
        }
        float cl[8]; cl[0] = lw[0];
#pragma unroll
        for (int e = 1; e < 8; ++e) cl[e] = cl[e - 1] + lw[e];
        tot[w * 64 + lane] = cl[7];
        __syncthreads();
        float off = 0.f, cumL = 0.f;
#pragma unroll
        for (int q = 0; q < 8; ++q) { const float tq = tot[q * 64 + lane]; cumL += tq; if (q < w) off += tq; }
        const float eL = __expf(cumL);
        float eGp = __expf(off);
#pragma unroll
        for (int e = 0; e < 8; ++e) {
            const int s = 8 * w + e; const float cum = off + cl[e];
            const float eG = __expf(cum), eGx = eGp, eI = __builtin_amdgcn_rcpf(eG), eB = eL * eI;
            eGp = eG;
            const int o = s * MROW + lane * 2;
            const unsigned p0 = cvtpk_c(nn[e] * eGx, r[e] * eG), p1 = cvtpk_c(bb[e] * eI, kp[e] * eI), p2 = cvtpk_c(bb[e] * eB, kp[e] * eB), p3 = cvtpk_c(vv[e], vv[e]);
            *(LAS bf16_t*)(lds + L_NT + o) = (bf16_t)p0; *(LAS bf16_t*)(lds + L_RT + o) = (bf16_t)(p0 >> 16);
            *(LAS bf16_t*)(lds + L_BH + o) = (bf16_t)p1; *(LAS bf16_t*)(lds + L_KH + o) = (bf16_t)(p1 >> 16);
            *(LAS bf16_t*)(lds + L_BB + o) = (bf16_t)p2; *(LAS bf16_t*)(lds + L_KB + o) = (bf16_t)(p2 >> 16);
            *(LAS bf16_t*)(lds + L_VV + o) = (bf16_t)p3;
        }
        __syncthreads();
        if (w == 0) tot[lane] = eL;
    }
    for (int rep_ = 0; rep_ < (SA_PROBE == 2 ? 2 : 1); ++rep_) {
        LAS float* anb = (LAS float*)(lds + L_ANB);
#pragma unroll
        for (int tt = 0; tt < 2; ++tt) {
            const int t = w + 8 * tt, sb = t >> 2, jb = t & 3, s0 = 16 * sb, j0 = 16 * jb;
            const int sx = s0 + i, jy = j0 + 4 * g;
            f32x4 cnb = {0.f, 0.f, 0.f, 0.f}, cnk = cnb, crb = cnb, crk = cnb;
            if (jb <= sb) {
#pragma unroll
                for (int k0 = 0; k0 < 64; k0 += 32) {
                    const bf16x8 fb = frag_row(lds + L_BH, j0, k0, g, i), fk = frag_row(lds + L_KH, j0, k0, g, i), fn = frag_row(lds + L_NT, s0, k0, g, i), fr = frag_row(lds + L_RT, s0, k0, g, i);
                    cnb = MFMA16(fb, fn, cnb); cnk = MFMA16(fk, fn, cnk); crb = MFMA16(fb, fr, crb); crk = MFMA16(fk, fr, crk);
                }
#pragma unroll
                for (int q = 0; q < 4; ++q) { const int j = jy + q; if (j >= sx) { cnb[q] = 0.f; cnk[q] = 0.f; } if (j > sx) { crb[q] = 0.f; crk[q] = 0.f; } }
            }
#pragma unroll
            for (int q = 0; q < 4; ++q) { const int j = jy + q; anb[sx * 64 + (j & 7) * 8 + (j >> 3)] = cnb[q]; }
            if (jb == sb && (i >> 3) == (g >> 1)) *(LAS f32x4*)(lds + L_DG + ((sx >> 3) * 64 + (sx & 7) * 8 + 4 * (g & 1)) * 4) = cnb;
            st_bf16x4(lds + L_ANK, sx, jy, cnk); st_bf16x4(lds + L_ARB, sx, jy, crb); st_bf16x4(lds + L_ARK, sx, jy, crk);
        }
    }
    __syncthreads();
    for (int rep_ = 0; rep_ < (SA_PROBE == 3 ? 2 : 1); ++rep_) {
        const int b = (w < 4) ? w : 11 - w;
        const int cl_ = lane >> 3, js = lane & 7, col = 8 * b + cl_;
        int zv = 0; asm volatile("" : "+v"(zv));
        const LAS float* anb = (const LAS float*)(lds + L_ANB) + js * 8;
        const LAS float* dgp = (const LAS float*)(lds + L_DG) + zv;
        float tj[8];
#pragma unroll
        for (int q = 0; q < 8; ++q) tj[q] = 0.f;
#pragma unroll
        for (int rb = 0; rb < 8; ++rb) {
            if (rb >= b) {
                f32x4 a0[8], a1[8], d0[8], d1[8];
#pragma unroll
                for (int r = 0; r < 8; ++r) {
                    if (rb > 0) a0[r] = *(const LAS f32x4*)(anb + (8 * rb + r) * 64);
                    if (rb > 4) a1[r] = *(const LAS f32x4*)(anb + (8 * rb + r) * 64 + 4);
                    if (r > 0) d0[r] = *(const LAS f32x4*)(dgp + rb * 64 + r * 8);
                    if (r > 4) d1[r] = *(const LAS f32x4*)(dgp + rb * 64 + r * 8 + 4);
                }
                asm volatile("s_waitcnt lgkmcnt(0)" ::: "memory");
                float x[8];
                if (rb > b) {
#pragma unroll
                    for (int q = 0; q < rb; ++q) {
                        const int e = q & 3;
                        if (q == 0) oct_mul8(x, a0[0][0], a0[1][0], a0[2][0], a0[3][0], a0[4][0], a0[5][0], a0[6][0], a0[7][0], tj[0]);
                        else if (q < 4) oct_fma8(x, a0[0][e], a0[1][e], a0[2][e], a0[3][e], a0[4][e], a0[5][e], a0[6][e], a0[7][e], tj[q]);
                        else oct_fma8(x, a1[0][e], a1[1][e], a1[2][e], a1[3][e], a1[4][e], a1[5][e], a1[6][e], a1[7][e], tj[q]);
                    }
                    oct_dpp_sum8(x);
                } else {
#pragma unroll
                    for (int r = 0; r < 8; ++r) x[r] = (cl_ == r) ? 1.f : 0.f;
                }
#pragma unroll
                for (int c = 0; c < 7; ++c) {
                    float l[7];
#pragma unroll
                    for (int k = 0; k < 7; ++k) { const int r = (c + 1 + k < 8) ? c + 1 + k : 7; l[k] = (c < 4) ? d0[r][c & 3] : d1[r][c & 3]; }
                    const int n = 7 - c;
                    if (c == 0) oct_col(n, x[1], x[2], x[3], x[4], x[5], x[6], x[7], l[0], l[1], l[2], l[3], l[4], l[5], l[6], x[0]);
                    else if (c == 1) oct_col(n, x[2], x[3], x[4], x[5], x[6], x[7], x[7], l[0], l[1], l[2], l[3], l[4], l[5], l[6], x[1]);
                    else if (c == 2) oct_col(n, x[3], x[4], x[5], x[6], x[7], x[7], x[7], l[0], l[1], l[2], l[3], l[4], l[5], l[6], x[2]);
                    else if (c == 3) oct_col(n, x[4], x[5], x[6], x[7], x[7], x[7], x[7], l[0], l[1], l[2], l[3], l[4], l[5], l[6], x[3]);
                    else if (c == 4) oct_col(n, x[5], x[6], x[7], x[7], x[7], x[7], x[7], l[0], l[1], l[2], l[3], l[4], l[5], l[6], x[4]);
                    else if (c == 5) oct_col(n, x[6], x[7], x[7], x[7], x[7], x[7], x[7], l[0], l[1], l[2], l[3], l[4], l[5], l[6], x[5]);
                    else oct_col(n, x[7], x[7], x[7], x[7], x[7], x[7], x[7], l[0], l[1], l[2], l[3], l[4], l[5], l[6], x[6]);
                }
                const bool m1 = (js & 1) != 0, m2 = (js & 2) != 0, m4 = (js & 4) != 0;
                const float v01 = m1 ? x[1] : x[0], v23 = m1 ? x[3] : x[2], v45 = m1 ? x[5] : x[4], v67 = m1 ? x[7] : x[6];
                const float v03 = m2 ? v23 : v01, v47 = m2 ? v67 : v45;
                const float v = m4 ? v47 : v03;
                tj[rb] = v;
            }
        }
#pragma unroll
        for (int q = 0; q < 8; q += 2) { const unsigned pt = cvtpk_c(tj[q], tj[q + 1]); *(LAS bf16_t*)(lds + L_TM + (js + 8 * q) * MROW + col * 2) = (bf16_t)pt; *(LAS bf16_t*)(lds + L_TM + (js + 8 * q + 8) * MROW + col * 2) = (bf16_t)(pt >> 16); }
    }
    for (int rep_ = 0; rep_ < (SA_PROBE == 4 ? 2 : 1); ++rep_) {
#pragma unroll
        for (int tt = 0; tt < 2; ++tt) {
            const int t = w + 8 * tt, x0 = 16 * (t >> 2), y0 = 16 * (t & 3);
            f32x4 c = {0.f, 0.f, 0.f, 0.f};
#pragma unroll
            for (int k0 = 0; k0 < 64; k0 += 32) c = MFMA16(frag_col(lds + L_VV, k0, y0, g, i), frag_row(lds + L_ANK, x0, k0, g, i), c);
            st_bf16x4(lds + L_X1, x0 + i, y0 + 4 * g, c);
        }
    }
    __syncthreads();
    if (SCAN_DEBUG && dbg) {
        const int j = tid >> 3, v0 = (tid & 7) * 8; bool bad = false;
        _Pragma("nounroll") for (int q = 0; q < 8; ++q) { float ref = 0.f; _Pragma("nounroll") for (int jp = 0; jp < 64; ++jp) ref += img_at(lds + L_ANK, j, jp) * img_at(lds + L_VV, jp, v0 + q); bad |= dbg_bad(img_at(lds + L_X1, j, v0 + q), ref); }
        dbg_flag(dbg, bad, 1u);
        __syncthreads();
    }
    for (int rep_ = 0; rep_ < (SA_PROBE == 5 ? 2 : 1); ++rep_) {
#pragma unroll
        for (int tt = 0; tt < 2; ++tt) {
            const int t = w + 8 * tt, x0 = 16 * (t >> 2), y0 = 16 * (t & 3);
            f32x4 cw = {0.f, 0.f, 0.f, 0.f}, cn = cw;
#pragma unroll
            for (int k0 = 0; k0 < 64; k0 += 32) { const bf16x8 ft = frag_row(lds + L_TM, x0, k0, g, i); cw = MFMA16(frag_col(lds + L_X1, k0, y0, g, i), ft, cw); cn = MFMA16(frag_col(lds + L_NT, k0, y0, g, i), ft, cn); }
            st_bf16x4(lds + L_WH, x0 + i, y0 + 4 * g, cw); st_bf16x4(lds + L_NH, x0 + i, y0 + 4 * g, cn);
        }
    }
    __syncthreads();
    if (SCAN_DEBUG && dbg) {
        const int sr = tid >> 3, v0 = (tid & 7) * 8; bool badw = false, badn = false;
        _Pragma("nounroll") for (int q = 0; q < 8; ++q) { float rw = 0.f, rn = 0.f; _Pragma("nounroll") for (int j = 0; j < 64; ++j) { const float tv = img_at(lds + L_TM, sr, j); rw += tv * img_at(lds + L_X1, j, v0 + q); rn += tv * img_at(lds + L_NT, j, v0 + q); }
            badw |= dbg_bad(img_at(lds + L_WH, sr, v0 + q), rw); badn |= dbg_bad(img_at(lds + L_NH, sr, v0 + q), rn); }
        dbg_flag(dbg, badw, 2u); dbg_flag(dbg, badn, 4u);
        __syncthreads();
    }
}
__device__ __forceinline__ void chunk_pq_tile(const LAS unsigned char* lds, int x0, int y0, int g, int i, f32x4& cp, f32x4& cq) {
    cp = (f32x4){0.f, 0.f, 0.f, 0.f}; cq = cp;
#pragma unroll
    for (int k0 = 0; k0 < 64; k0 += 32) {
        const bf16x8 fb = frag_col(lds + L_BB, k0, x0, g, i), fk = frag_col(lds + L_KB, k0, x0, g, i);
        cp = MFMA16(frag_col(lds + L_NH, k0, y0, g, i), fb, cp);
        cq = MFMA16(frag_col(lds + L_WH, k0, y0, g, i), fb, cq); cq = MFMA16(frag_col(lds + L_VV, k0, y0, g, i), fk, cq);
    }
    const float gm = ((const LAS float*)(lds + L_TOT))[x0 + i];
#pragma unroll
    for (int q = 0; q < 4; ++q) if (y0 + 4 * g + q == x0 + i) cp[q] += gm;
}

struct ScanBufs { bf16_t* pm; bf16_t* qm; bf16_t* rh; bf16_t* yh; bf16_t* st; float* bonus; };
constexpr int NCHUNK = T / CL;
__device__ __forceinline__ void g_st4(bf16_t* p, const f32x4& v) { u32x2 w; w.x = cvtpk_c(v[0], v[1]); w.y = cvtpk_c(v[2], v[3]); *(u32x2*)p = w; }
__device__ __forceinline__ void scan_sa(LAS unsigned char* lds, const ScanArgs& a, const ScanBufs& sb, int G, int bid) {
    const int tid = threadIdx.x, lane = tid & 63, w = __builtin_amdgcn_readfirstlane(tid >> 6), g = lane >> 4, i = lane & 15;
    const int total = BATCH * NH * NCHUNK, per = (total + G - 1) / G;
    const int gc_end = ((bid + 1) * per < total) ? (bid + 1) * per : total;
    ChunkRaw raw;
    if (bid * per < gc_end) { const int gc = bid * per, bh = gc >> 7, c = gc & (NCHUNK - 1); chunk_load(raw, a, (size_t)(bh >> 4) * T + (size_t)c * CL, bh & 15); }
    for (int gc = bid * per; gc < gc_end; ++gc) {
        const int bh = gc >> 7, h = bh & 15;
        __syncthreads();
        ChunkRaw cur = raw;
        if (gc + 1 < gc_end) { const int g2 = gc + 1, bh2 = g2 >> 7, c2 = g2 & (NCHUNK - 1); chunk_load(raw, a, (size_t)(bh2 >> 4) * T + (size_t)c2 * CL, bh2 & 15); }
        chunk_build(lds, a, cur, h, sb.bonus + (size_t)gc * CL, nullptr);
        const size_t ob = (size_t)gc * 4096;
        for (int rep_ = 0; rep_ < (SA_PROBE == 6 ? 2 : 1); ++rep_)
#pragma unroll
        for (int tt = 0; tt < 2; ++tt) {
            const int t = w + 8 * tt, x0 = 16 * (t >> 2), y0 = 16 * (t & 3), x = x0 + i, y = y0 + 4 * g;
            f32x4 cr = {0.f, 0.f, 0.f, 0.f}, cy = cr;
#pragma unroll
            for (int k0 = 0; k0 < 64; k0 += 32) {
                const bf16x8 fa = frag_row(lds + L_ARB, x0, k0, g, i), fk = frag_row(lds + L_ARK, x0, k0, g, i);
                cr = MFMA16(frag_col(lds + L_NH, k0, y0, g, i), fa, cr);
                cy = MFMA16(frag_col(lds + L_WH, k0, y0, g, i), fa, cy); cy = MFMA16(frag_col(lds + L_VV, k0, y0, g, i), fk, cy);
            }
            const u32x2 rt = *(const LAS u32x2*)(lds + L_RT + x * MROW + y * 2);
            cr[0] += bflo(rt.x); cr[1] += bfhi(rt.x); cr[2] += bflo(rt.y); cr[3] += bfhi(rt.y);
            g_st4(sb.rh + ob + x * 64 + y, cr); g_st4(sb.yh + ob + x * 64 + y, cy);
            f32x4 cp, cq; chunk_pq_tile(lds, x0, y0, g, i, cp, cq);
            g_st4(sb.pm + ob + x * 64 + y, cp); g_st4(sb.qm + ob + x * 64 + y, cq);
        }
    }
}
__device__ __forceinline__ void scan_sb(LAS unsigned char* lds, const ScanBufs& sb, int G, int bid) {
    const int tid = threadIdx.x, lane = tid & 63, w = __builtin_amdgcn_readfirstlane(tid >> 6), g = lane >> 4, i = lane & 15;
    const int srow = tid >> 3, sch = tid & 7, soff = srow * MROW + sch * 16;
    for (int bh = bid; bh < BATCH * NH; bh += G) {
        __syncthreads();
        *(LAS u32x4*)(lds + soff) = (u32x4){0u, 0u, 0u, 0u};
        const size_t gb = (size_t)bh * NCHUNK * 4096;
        u32x4 pmr = *(const u32x4*)(sb.pm + gb + srow * 64 + sch * 8);
        u32x2 qn[2];
#pragma unroll
        for (int tt = 0; tt < 2; ++tt) { const int t = w + 8 * tt; qn[tt] = *(const u32x2*)(sb.qm + gb + (16 * (t >> 2) + i) * 64 + 16 * (t & 3) + 4 * g); }
        for (int c = 0; c < NCHUNK; ++c) {
            const size_t ob = gb + (size_t)c * 4096;
            *(LAS u32x4*)(lds + (2 + (c & 1)) * MSZ + soff) = pmr;
            if (c + 1 < NCHUNK) pmr = *(const u32x4*)(sb.pm + ob + 4096 + srow * 64 + sch * 8);
            u32x2 qv[2] = {qn[0], qn[1]};
            if (c + 1 < NCHUNK) {
#pragma unroll
                for (int tt = 0; tt < 2; ++tt) { const int t = w + 8 * tt; qn[tt] = *(const u32x2*)(sb.qm + ob + 4096 + (16 * (t >> 2) + i) * 64 + 16 * (t & 3) + 4 * g); }
            }
            __syncthreads();
            const LAS unsigned char* scur = lds + (c & 1) * MSZ; LAS unsigned char* snxt = lds + ((c + 1) & 1) * MSZ; const LAS unsigned char* pimg = lds + (2 + (c & 1)) * MSZ;
            if (c > 0) *(u32x4*)(sb.pm + ob - 4096 + srow * 64 + sch * 8) = *(const LAS u32x4*)(scur + soff);
#pragma unroll
            for (int tt = 0; tt < 2; ++tt) {
                const int t = w + 8 * tt, x0 = 16 * (t >> 2), y0 = 16 * (t & 3);
                f32x4 acc = {bflo(qv[tt].x), bfhi(qv[tt].x), bflo(qv[tt].y), bfhi(qv[tt].y)};
#pragma unroll
                for (int k0 = 0; k0 < 64; k0 += 32) acc = MFMA16(frag_col(scur, k0, y0, g, i), frag_row(pimg, x0, k0, g, i), acc);
                st_bf16x4(snxt, x0 + i, y0 + 4 * g, acc);
            }
        }
    }
}
__device__ __forceinline__ void scan_sc(LAS unsigned char* lds, const ScanArgs& a, const ScanBufs& sb, int G, int bid) {
    const int tid = threadIdx.x, lane = tid & 63, w = __builtin_amdgcn_readfirstlane(tid >> 6), g = lane >> 4, i = lane & 15, half = w >> 2, wq = w & 3;
    const int ht = tid & 255, srow = ht >> 2, sch = ht & 3;
    LAS unsigned char* rimg = lds + half * 2 * MSZ; LAS unsigned char* simg = rimg + MSZ;
    const int total = BATCH * NH * NCHUNK / 2, per = (total + G - 1) / G;
    for (int pc = bid * per; pc < (bid + 1) * per && pc < total; ++pc) {
        const int gc = 2 * pc + half, bh = gc >> 7, c = gc & (NCHUNK - 1), b = bh >> 4, h = bh & 15;
        const size_t ob = (size_t)gc * 4096, m0 = (size_t)b * T + (size_t)c * CL;
        __syncthreads();
#pragma unroll
        for (int q = 0; q < 2; ++q) { const int ch = sch + 4 * q;
            *(LAS u32x4*)(rimg + srow * MROW + ch * 16) = *(const u32x4*)(sb.rh + ob + srow * 64 + ch * 8);
            *(LAS u32x4*)(simg + srow * MROW + ch * 16) = c > 0 ? *(const u32x4*)(sb.pm + ob - 4096 + srow * 64 + ch * 8) : (u32x4){0u, 0u, 0u, 0u}; }
        __syncthreads();
        const int x0 = 16 * wq, s = x0 + i; const size_t m = m0 + s;
        f32x4 y[4]; float sum = 0.f;
#pragma unroll
        for (int vt = 0; vt < 4; ++vt) {
            const u32x2 yv = *(const u32x2*)(sb.yh + ob + s * 64 + 16 * vt + 4 * g);
            f32x4 acc = {bflo(yv.x), bfhi(yv.x), bflo(yv.y), bfhi(yv.y)};
#pragma unroll
            for (int k0 = 0; k0 < 64; k0 += 32) acc = MFMA16(frag_col(simg, k0, 16 * vt, g, i), frag_row(rimg, x0, k0, g, i), acc);
            y[vt] = acc; sum += (acc[0] + acc[1]) + (acc[2] + acc[3]);
        }
        const float mean = xsum4(sum) * (1.0f / 64.0f); float sq = 0.f;
#pragma unroll
        for (int vt = 0; vt < 4; ++vt) { y[vt] = y[vt] - mean; sq += (y[vt][0] * y[vt][0] + y[vt][1] * y[vt][1]) + (y[vt][2] * y[vt][2] + y[vt][3] * y[vt][3]); }
        const float rstd = __builtin_amdgcn_rsqf(xsum4(sq) * (1.0f / 64.0f) + LNX_EPS);
        const float bo = sb.bonus[(size_t)gc * CL + s];
#pragma unroll
        for (int vt = 0; vt < 4; ++vt) {
            const int v0 = h * 64 + 16 * vt + 4 * g;
            const f32x4 lg = *(const f32x4*)(a.lnx_g + v0), lb = *(const f32x4*)(a.lnx_b + v0);
            const u32x2 vc = *(const u32x2*)(a.zr + m * RC + 2048 + v0), gg = *(const u32x2*)(a.ymix + m * D + v0);
            const u32x2 vp = ((m & (T - 1)) == 0) ? (u32x2){0u, 0u} : *(const u32x2*)(a.zr + (m - 1) * RC + 2048 + v0);
            const f32x4 mv = *(const f32x4*)(a.mu + 2048 + v0);
            const float vs0 = bflo(vc.x) + (bflo(vp.x) - bflo(vc.x)) * mv[0], vs1 = bfhi(vc.x) + (bfhi(vp.x) - bfhi(vc.x)) * mv[1], vs2 = bflo(vc.y) + (bflo(vp.y) - bflo(vc.y)) * mv[2], vs3 = bfhi(vc.y) + (bfhi(vp.y) - bfhi(vc.y)) * mv[3];
            f32x4 o;
            o[0] = (y[vt][0] * rstd * lg[0] + lb[0] + bo * vs0) * bflo(gg.x); o[1] = (y[vt][1] * rstd * lg[1] + lb[1] + bo * vs1) * bfhi(gg.x);
            o[2] = (y[vt][2] * rstd * lg[2] + lb[2] + bo * vs2) * bflo(gg.y); o[3] = (y[vt][3] * rstd * lg[3] + lb[3] + bo * vs3) * bfhi(gg.y);
            g_st4(a.ymix + m * D + v0, o);
        }
    }
}

#define TK_INS(t, xin) do { float x_ = (xin); _Pragma("unroll") for (int j_ = 0; j_ < 16; ++j_) { const float hi_ = fmaxf(t[j_], x_); x_ = fminf(t[j_], x_); t[j_] = hi_; } } while (0)
#define CE_DESC(a, b) do { const float hi_ = fmaxf(a, b), lo_ = fminf(a, b); a = hi_; b = lo_; } while (0)
__device__ __forceinline__ void sort16_desc(float (&v)[16]) {
#pragma unroll
    for (int k = 2; k <= 16; k <<= 1)
#pragma unroll
        for (int j = k >> 1; j > 0; j >>= 1)
#pragma unroll
            for (int i = 0; i < 16; ++i) { const int l = i ^ j; if (l > i) { if ((i & k) == 0) CE_DESC(v[i], v[l]); else CE_DESC(v[l], v[i]); } }
}
__device__ __forceinline__ void merge16_desc(float (&t)[16], const float (&v)[16]) {
#pragma unroll
    for (int i = 0; i < 16; ++i) t[i] = fmaxf(t[i], v[15 - i]);
#pragma unroll
    for (int j = 8; j > 0; j >>= 1)
#pragma unroll
        for (int i = 0; i < 16; ++i) { const int l = i ^ j; if (l > i) CE_DESC(t[i], t[l]); }
}
__device__ __forceinline__ void topk_phase(LAS unsigned char* lds, const float* s, int* eidx, float* gates, int G, int bid) {
    const int tid = threadIdx.x;
    LAS unsigned short* el = (LAS unsigned short*)lds;
    LAS float* buf = (LAS float*)(lds + 50 * 512 * 2);
    for (int blk = bid; blk < M * PH / 512; blk += G) {
        const float* sb = s + (size_t)blk * 512 * 256;
        float ta[16], tb[16], tc[16];
#pragma unroll
        for (int j = 0; j < 16; ++j) { ta[j] = -INFINITY; tb[j] = -INFINITY; tc[j] = -INFINITY; }
        f32x4 pre[8];
#pragma unroll
        for (int q = 0; q < 8; ++q) { const int idx = tid + 512 * q, f4 = idx & 7; pre[q] = *(const f32x4*)(sb + (size_t)(idx >> 3) * 256 + (f4 >> 2) * 128 + (f4 & 3) * 4); }
#pragma unroll
        for (int cc = 0; cc < 8; ++cc) {
            __syncthreads();
#pragma unroll
            for (int q = 0; q < 8; ++q) { const int idx = tid + 512 * q; LAS float* d = buf + (idx >> 3) * 33 + (idx & 7) * 4; d[0] = pre[q][0]; d[1] = pre[q][1]; d[2] = pre[q][2]; d[3] = pre[q][3]; }
            if (cc + 1 < 8) {
#pragma unroll
                for (int q = 0; q < 8; ++q) { const int idx = tid + 512 * q, f4 = idx & 7; pre[q] = *(const f32x4*)(sb + (size_t)(idx >> 3) * 256 + (f4 >> 2) * 128 + (cc + 1) * 16 + (f4 & 3) * 4); }
            }
            __syncthreads();
            float va[16], vb[16];
#pragma unroll
            for (int j = 0; j < 16; ++j) {
                const float fa = buf[tid * 33 + j], fb = buf[tid * 33 + 16 + j];
                va[j] = __uint_as_float((__float_as_uint(fa) & ~127u) | (unsigned)(cc * 16 + j)); vb[j] = __uint_as_float((__float_as_uint(fb) & ~127u) | (unsigned)(cc * 16 + j));
            }
            sort16_desc(va); sort16_desc(vb);
            if (cc == 0) {
#pragma unroll
                for (int j = 0; j < 16; ++j) { ta[j] = va[j]; tb[j] = vb[j]; }
            } else { merge16_desc(ta, va); merge16_desc(tb, vb); }
        }
        int kc = 0;
        float cv[4][16];
#pragma unroll
        for (int gq = 0; gq < 4; ++gq)
#pragma unroll
            for (int j = 0; j < 16; ++j) cv[gq][j] = -INFINITY;
#pragma unroll
        for (int i = 0; i < 16; ++i)
#pragma unroll
            for (int j = 0; j < 16; ++j)
                if ((i + 1) * (j + 1) <= 16) {
                    const unsigned ba = __float_as_uint(ta[i]), bb = __float_as_uint(tb[j]);
                    const float sum = __uint_as_float(ba & ~127u) + __uint_as_float(bb & ~127u);
                    const float xc = __uint_as_float((__float_as_uint(sum) & ~63u) | (unsigned)kc);
                    el[kc * 512 + tid] = (unsigned short)(((ba & 127u) << 7) | (bb & 127u));
                    cv[kc >> 4][kc & 15] = xc;
                    ++kc;
                }
#pragma unroll
        for (int gq = 0; gq < 4; ++gq) sort16_desc(cv[gq]);
#pragma unroll
        for (int j = 0; j < 16; ++j) tc[j] = cv[0][j];
        merge16_desc(tc, cv[1]); merge16_desc(tc, cv[2]); merge16_desc(tc, cv[3]);
        float ex[16], den = 0.f;
#pragma unroll
        for (int j = 0; j < 16; ++j) { ex[j] = __expf(tc[j] - tc[0]); den += ex[j]; }
        const float inv = 1.0f / den;
        int ev[16];
#pragma unroll
        for (int j = 0; j < 16; ++j) ev[j] = (int)el[(__float_as_uint(tc[j]) & 63u) * 512 + tid];
        const size_t idx = (size_t)blk * 512 + tid;
        int* eo = eidx + idx * 16; float* go = gates + idx * 16;
#pragma unroll
        for (int j = 0; j < 16; j += 4) { *(int4*)(eo + j) = make_int4(ev[j], ev[j + 1], ev[j + 2], ev[j + 3]);
            *(f32x4*)(go + j) = (f32x4){ex[j] * inv, ex[j + 1] * inv, ex[j + 2] * inv, ex[j + 3] * inv}; }
    }
}

__device__ __forceinline__ float gelu_tanh(float x) { const float u = 0.7978845608028654f * (x + 0.044715f * x * x * x); const float t = 1.0f - 2.0f / (__expf(2.0f * u) + 1.0f); return 0.5f * x * (1.0f + t); }
__device__ __forceinline__ void quant_u4(const float* src, unsigned char* dst, float* scale, int G, int bid) {
    const int lane = threadIdx.x & 63, wave = __builtin_amdgcn_readfirstlane(threadIdx.x >> 6);
    for (int e = bid * NWAVES + wave; e < NEXP; e += G * NWAVES) {
        const f32x4* r = (const f32x4*)(src + (size_t)e * D + 32 * lane);
        f32x4 v[8]; float mx = 0.f, sq = 0.f;
#pragma unroll
        for (int q = 0; q < 8; ++q) { const f32x4 t = r[q]; v[q] = t; mx = fmaxf(mx, fmaxf(fmaxf(fabsf(t[0]), fabsf(t[1])), fmaxf(fabsf(t[2]), fabsf(t[3])))); sq += (t[0] * t[0] + t[1] * t[1]) + (t[2] * t[2] + t[3] * t[3]); }
#pragma unroll
        for (int o = 1; o < 64; o <<= 1) { mx = fmaxf(mx, __shfl_xor(mx, o)); sq += __shfl_xor(sq, o); }
        const float sc = fmaxf(fmaxf(0.335f * sqrtf(sq * (1.0f / D)), mx * (1.0f / 20.0f)), 1e-30f), inv = 1.0f / sc;
        if (lane == 0) scale[e] = sc;
        u32x4 o;
#pragma unroll
        for (int p = 0; p < 4; ++p) { unsigned w = 0u;
#pragma unroll
            for (int k = 0; k < 4; ++k) {
                const int lo = min(max(__float2int_rn(v[2 * p][k] * inv), -7), 7) + 8, hi = min(max(__float2int_rn(v[2 * p + 1][k] * inv), -7), 7) & 15;
                w |= (unsigned)(lo | (hi << 4)) << (8 * k); }
            o[p] = w; }
        *(u32x4*)(dst + (size_t)e * 1024 + 16 * lane) = o;
    }
}
__device__ __forceinline__ void quant_v8(const float* src, unsigned char* dst, float* scale, int G, int bid) {
    const int lane = threadIdx.x & 63, wave = __builtin_amdgcn_readfirstlane(threadIdx.x >> 6);
    for (int e = bid * NWAVES + wave; e < NEXP; e += G * NWAVES) {
        const f32x4* r = (const f32x4*)(src + (size_t)e * D + 32 * lane);
        f32x4 v[8]; float mx = 0.f;
#pragma unroll
        for (int q = 0; q < 8; ++q) { const f32x4 t = r[q]; v[q] = t; mx = fmaxf(mx, fmaxf(fmaxf(fabsf(t[0]), fabsf(t[1])), fmaxf(fabsf(t[2]), fabsf(t[3])))); }
#pragma unroll
        for (int o = 1; o < 64; o <<= 1) mx = fmaxf(mx, __shfl_xor(mx, o));
        const float sc = fmaxf(mx, 1e-30f) * (1.0f / 127.0f), inv = 1.0f / sc;
        if (lane == 0) scale[e] = sc;
#pragma unroll
        for (int hq = 0; hq < 2; ++hq) { u32x4 o;
#pragma unroll
            for (int p = 0; p < 4; ++p) { const f32x4 t = v[4 * hq + p];
                o[p] = ((unsigned)__float2int_rn(t[0] * inv) & 0xffu) | (((unsigned)__float2int_rn(t[1] * inv) & 0xffu) << 8) | (((unsigned)__float2int_rn(t[2] * inv) & 0xffu) << 16) | ((unsigned)__float2int_rn(t[3] * inv) << 24); }
            *(u32x4*)(dst + (size_t)e * D + 32 * lane + 16 * hq) = o; }
    }
}

struct GatherArgs { const bf16_t* h1; bf16_t* h2; const float* ss2; const float* g2; const unsigned char* uq; const unsigned char* vq; const float* su; const float* sv; const int* eidx; const float* gates; bf16_t* hb; float* rs3; };
__device__ __forceinline__ float wave_max_all(float v) {
#pragma unroll
    for (int o = 1; o < 64; o <<= 1) v = fmaxf(v, __shfl_xor(v, o));
    return v;
}
__device__ __forceinline__ int wave_isum_to63(int v) {
    v += __builtin_amdgcn_update_dpp(0, v, 0x111, 0xF, 0xF, true);
    v += __builtin_amdgcn_update_dpp(0, v, 0x112, 0xF, 0xF, true);
    v += __builtin_amdgcn_update_dpp(0, v, 0x114, 0xF, 0xF, true);
    v += __builtin_amdgcn_update_dpp(0, v, 0x118, 0xF, 0xF, true);
    v += __builtin_amdgcn_update_dpp(0, v, 0x142, 0xA, 0xF, false);
    v += __builtin_amdgcn_update_dpp(0, v, 0x143, 0xC, 0xF, false);
    return v;
}
template <bool LOCAL> __device__ __forceinline__ void gather_phase(const GatherArgs& a, int G, int bid) {
    const int tid = threadIdx.x, lane = tid & 63, wave = __builtin_amdgcn_readfirstlane(tid >> 6);
    for (int m = LOCAL ? 64 * bid + wave : bid * NWAVES + wave; m < (LOCAL ? 64 * bid + 64 : M); m += (LOCAL ? NWAVES : G * NWAVES)) {
        const float rs = 1.0f / sqrtf(a.ss2[m] * (1.0f / D) + NORM_EPS);
        int xq[8]; int xsum = 0; float sx; u32x4 h1p[4];
        {
            float x[32]; float mx = 0.f;
#pragma unroll
            for (int q = 0; q < 4; ++q) { h1p[q] = *(const u32x4*)(a.h1 + (size_t)m * D + 32 * lane + 8 * q);
                const f32x4 ga = *(const f32x4*)(a.g2 + 32 * lane + 8 * q), gb = *(const f32x4*)(a.g2 + 32 * lane + 8 * q + 4);
                const float hv[8] = {bflo(h1p[q].x), bfhi(h1p[q].x), bflo(h1p[q].y), bfhi(h1p[q].y), bflo(h1p[q].z), bfhi(h1p[q].z), bflo(h1p[q].w), bfhi(h1p[q].w)};
                const float gv[8] = {ga[0], ga[1], ga[2], ga[3], gb[0], gb[1], gb[2], gb[3]};
#pragma unroll
                for (int e = 0; e < 8; ++e) { const float xv = hv[e] * rs * gv[e]; x[8 * q + e] = xv; mx = fmaxf(mx, fabsf(xv)); } }
            mx = wave_max_all(mx);
            sx = fmaxf(mx, 1e-30f) * (1.0f / 127.0f); const float inv = 1.0f / sx;
#pragma unroll
            for (int k = 0; k < 8; ++k) { const int q0 = __float2int_rn(x[4 * k] * inv), q1 = __float2int_rn(x[4 * k + 1] * inv), q2 = __float2int_rn(x[4 * k + 2] * inv), q3 = __float2int_rn(x[4 * k + 3] * inv);
                if ((k & 1) == 0) xsum += (q0 + q1) + (q2 + q3); xq[k] = (int)(((unsigned)q0 & 0xffu) | (((unsigned)q1 & 0xffu) << 8) | (((unsigned)q2 & 0xffu) << 16) | ((unsigned)q3 << 24)); }
        }
        const int x8 = 128 * __builtin_amdgcn_readlane(wave_isum_to63(xsum), 63);
        const int e_lo = a.eidx[(size_t)m * 128 + lane], e_hi = a.eidx[(size_t)m * 128 + 64 + lane];
        int d_lo = 0, d_hi = 0;
#pragma unroll
        for (int hh = 0; hh < 2; ++hh) {
            const int ev = hh ? e_hi : e_lo; int dreg = 0;
#pragma unroll 2
            for (int q4 = 0; q4 < 16; ++q4) {
                u32x4 uw[4];
#pragma unroll
                for (int c = 0; c < 4; ++c) { const int e = __builtin_amdgcn_readlane(ev, q4 * 4 + c); uw[c] = *(const u32x4*)(a.uq + (size_t)e * 1024 + 16 * lane); }
#pragma unroll
                for (int c = 0; c < 4; ++c) { int p = 0, ph = 0;
#pragma unroll
                    for (int k = 0; k < 4; ++k) { const unsigned wv = uw[c][k]; p = __builtin_amdgcn_sdot4((int)(wv & 0x0F0F0F0Fu), xq[2 * k], p, false); ph = __builtin_amdgcn_sdot4((int)(wv & 0xF0F0F0F0u), xq[2 * k + 1], ph, false); }
                    const int tot = __builtin_amdgcn_readlane(wave_isum_to63(16 * p + ph), 63);
                    dreg = (lane == q4 * 4 + c) ? tot : dreg; }
            }
            if (hh) d_hi = dreg; else d_lo = dreg;
        }
        const float c_lo = a.gates[(size_t)m * 128 + lane] * gelu_tanh((float)(d_lo - x8) * (sx * 0.0625f * a.su[e_lo])) * a.sv[e_lo];
        const float c_hi = a.gates[(size_t)m * 128 + 64 + lane] * gelu_tanh((float)(d_hi - x8) * (sx * 0.0625f * a.su[e_hi])) * a.sv[e_hi];
        const float cmx = wave_max_all(fmaxf(fabsf(c_lo), fabsf(c_hi)));
        const float cs = fmaxf(cmx, 1e-30f) * (1.0f / 127.0f), cinv = 1.0f / cs;
        int pk_lo = (int)(((unsigned)__float2int_rn(c_lo * cinv) & 0xffu) << (8 * (lane & 3))), pk_hi = (int)(((unsigned)__float2int_rn(c_hi * cinv) & 0xffu) << (8 * (lane & 3)));
        pk_lo |= __builtin_amdgcn_update_dpp(0, pk_lo, 0xB1, 0xF, 0xF, true); pk_lo |= __builtin_amdgcn_update_dpp(0, pk_lo, 0x4E, 0xF, 0xF, true);
        pk_hi |= __builtin_amdgcn_update_dpp(0, pk_hi, 0xB1, 0xF, 0xF, true); pk_hi |= __builtin_amdgcn_update_dpp(0, pk_hi, 0x4E, 0xF, 0xF, true);
        int acc[32];
#pragma unroll
        for (int i = 0; i < 32; ++i) acc[i] = 0;
        const int cq8 = 8 * __builtin_amdgcn_readlane(wave_isum_to63(__float2int_rn(c_lo * cinv) + __float2int_rn(c_hi * cinv)), 63);
#pragma unroll
        for (int hh = 0; hh < 2; ++hh) {
            const int ev = hh ? e_hi : e_lo; const int pkv = hh ? pk_hi : pk_lo;
#pragma unroll 1
            for (int q4 = 0; q4 < 16; ++q4) {
                const int cpk = __builtin_amdgcn_readlane(pkv, q4 * 4);
                u32x4 vw[4];
#pragma unroll
                for (int c = 0; c < 4; ++c) { const int e = __builtin_amdgcn_readlane(ev, q4 * 4 + c); vw[c] = *(const u32x4*)(a.vq + (size_t)e * 1024 + 16 * lane); }
#pragma unroll
                for (int p = 0; p < 4; ++p) {
                    const unsigned A = vw[0][p], B = vw[1][p], C = vw[2][p], Dd = vw[3][p];
                    const unsigned ab_lo = __builtin_amdgcn_perm(B, A, 0x05010400u), ab_hi = __builtin_amdgcn_perm(B, A, 0x07030602u), cd_lo = __builtin_amdgcn_perm(Dd, C, 0x05010400u), cd_hi = __builtin_amdgcn_perm(Dd, C, 0x07030602u);
                    const unsigned t0 = __builtin_amdgcn_perm(cd_lo, ab_lo, 0x05040100u), t1 = __builtin_amdgcn_perm(cd_lo, ab_lo, 0x07060302u), t2 = __builtin_amdgcn_perm(cd_hi, ab_hi, 0x05040100u), t3 = __builtin_amdgcn_perm(cd_hi, ab_hi, 0x07060302u);
                    acc[8 * p + 0] = __builtin_amdgcn_sdot4((int)(t0 & 0x0F0F0F0Fu), cpk, acc[8 * p + 0], false); acc[8 * p + 4] = __builtin_amdgcn_sdot4((int)(t0 & 0xF0F0F0F0u), cpk, acc[8 * p + 4], false);
                    acc[8 * p + 1] = __builtin_amdgcn_sdot4((int)(t1 & 0x0F0F0F0Fu), cpk, acc[8 * p + 1], false); acc[8 * p + 5] = __builtin_amdgcn_sdot4((int)(t1 & 0xF0F0F0F0u), cpk, acc[8 * p + 5], false);
                    acc[8 * p + 2] = __builtin_amdgcn_sdot4((int)(t2 & 0x0F0F0F0Fu), cpk, acc[8 * p + 2], false); acc[8 * p + 6] = __builtin_amdgcn_sdot4((int)(t2 & 0xF0F0F0F0u), cpk, acc[8 * p + 6], false);
                    acc[8 * p + 3] = __builtin_amdgcn_sdot4((int)(t3 & 0x0F0F0F0Fu), cpk, acc[8 * p + 3], false); acc[8 * p + 7] = __builtin_amdgcn_sdot4((int)(t3 & 0xF0F0F0F0u), cpk, acc[8 * p + 7], false);
                }
            }
        }
#pragma unroll
        for (int p = 0; p < 4; ++p)
#pragma unroll
            for (int k = 0; k < 4; ++k) acc[8 * p + k] = 16 * (acc[8 * p + k] - cq8);

        float hn[32]; float ssq = 0.f, hmx = 0.f;
#pragma unroll
        for (int q = 0; q < 4; ++q) {
            const float hv[8] = {bflo(h1p[q].x), bfhi(h1p[q].x), bflo(h1p[q].y), bfhi(h1p[q].y), bflo(h1p[q].z), bfhi(h1p[q].z), bflo(h1p[q].w), bfhi(h1p[q].w)};
#pragma unroll
            for (int e = 0; e < 8; ++e) { const float nv = hv[e] + (cs * 0.0625f) * (float)acc[8 * q + e]; ssq += nv * nv; hmx = fmaxf(hmx, fabsf(nv)); hn[8 * q + e] = nv; }
            u32x4 w; w.x = pk2(hn[8 * q], hn[8 * q + 1]); w.y = pk2(hn[8 * q + 2], hn[8 * q + 3]); w.z = pk2(hn[8 * q + 4], hn[8 * q + 5]); w.w = pk2(hn[8 * q + 6], hn[8 * q + 7]);
            *(u32x4*)(a.h2 + (size_t)m * D + 32 * lane + 8 * q) = w;
        }
        ssq = wave_sum_dpp(ssq); hmx = wave_max_all(hmx);
        const float hstep = fmaxf(hmx, 1e-30f) * (1.0f / 127.0f), hinv = 1.0f / hstep;
        if (lane == 0) a.rs3[m] = hstep / sqrtf(ssq * (1.0f / D) + NORM_EPS);
#pragma unroll
        for (int hq = 0; hq < 2; ++hq) { u32x4 qw;
#pragma unroll
            for (int p = 0; p < 4; ++p) { const int b = 16 * hq + 4 * p; qw[p] = ((unsigned)__float2int_rn(hn[b] * hinv) & 0xffu) | (((unsigned)__float2int_rn(hn[b + 1] * hinv) & 0xffu) << 8) | (((unsigned)__float2int_rn(hn[b + 2] * hinv) & 0xffu) << 16) | ((unsigned)__float2int_rn(hn[b + 3] * hinv) << 24); }
            *(u32x4*)((unsigned char*)a.hb + (size_t)m * D + 32 * lane + 16 * hq) = qw; }
    }
}

__device__ __forceinline__ void final_phase(float* out, const bf16_t* h3, const float* ss4, const float* gf, int G, int bid, const unsigned* dbgw) {
    const float dshift = sqrtf(0.01f * (float)(*dbgw));
    const int lane = threadIdx.x & 63, wave = __builtin_amdgcn_readfirstlane(threadIdx.x >> 6);
    for (int m = bid * NWAVES + wave; m < M; m += G * NWAVES) {
        const float rs = 1.0f / sqrtf(ss4[m] * (1.0f / D) + NORM_EPS);
        const u32x4* hr = (const u32x4*)(h3 + (size_t)m * D) + lane; f32x4* r = (f32x4*)(out + (size_t)m * D) + 2 * lane; const f32x4* gp = (const f32x4*)gf + 2 * lane;
#pragma unroll
        for (int j = 0; j < 4; ++j) { const u32x4 hw = hr[64 * j]; const f32x4 g0 = gp[128 * j], g1 = gp[128 * j + 1];
            r[128 * j] = (f32x4){bflo(hw.x), bfhi(hw.x), bflo(hw.y), bfhi(hw.y)} * rs * g0 + dshift; r[128 * j + 1] = (f32x4){bflo(hw.z), bfhi(hw.z), bflo(hw.w), bfhi(hw.w)} * rs * g1 + dshift; }
    }
}

constexpr int N_PHASES = 16;
#ifndef MK_N_LAUNCHES
#define MK_N_LAUNCHES 1
#endif
struct Args { const float* in[26]; float* out; unsigned char* ws; int ph_lo, ph_hi; };
__global__ void __launch_bounds__(NWAVES * 64, 2) mk_fwd(Args args) {
    extern __shared__ __attribute__((aligned(16))) unsigned char lds_raw[];
    LAS unsigned char* lds = (LAS unsigned char*)lds_raw;
    volatile LAS unsigned* MISC = (volatile LAS unsigned*)(lds + MISC_OFF);
    const int tid = threadIdx.x;
    const int G = gridDim.x, bid = blockIdx.x;
    unsigned char* ws = args.ws;
    gu32* ctl = (gu32*)(ws + WS_CTL);
    for (int u = tid; u < (LDS_BYTES - LDSCTL_OFF) / 4; u += NWAVES * 64) ((LAS unsigned*)(lds + LDSCTL_OFF))[u] = 0u;
    __syncthreads();
    XcdBarrier bar; bar.bar = (unsigned*)(ctl + CW_BAR); bar.x = 0; bar.st = nullptr;
    if (MK_N_LAUNCHES == 1) bar = xcd_barrier_post((unsigned*)(ctl + CW_BAR), MISC + 8);
    const int lo = args.ph_lo, hi = args.ph_hi;
#ifndef PHASE_MASK
#define PHASE_MASK 0xFFFFFFFFu
#endif
#define IN(k) (((PHASE_MASK >> (k)) & 1u) && lo <= (k) && (k) < hi)
#define SEAM(k) do { if (IN(k) && IN((k) + 1)) xcd_barrier(bar); } while (0)
#ifndef REPEAT_MASK
#define REPEAT_MASK 0u
#endif
#define PHREP(k) for (int rep_ = 0; rep_ < (IN(k) ? (((REPEAT_MASK >> (k)) & 1u) ? 2 : 1) : 0); ++rep_, (void)(rep_ < (((REPEAT_MASK >> (k)) & 1u) ? 2 : 1) ? (xcd_barrier(bar), 0) : 0))

    const float* x = args.in[0]; float* out = args.out;
    bf16_t* win_t = (bf16_t*)(ws + WS_WIN); bf16_t* wout_t = (bf16_t*)(ws + WS_WOUT); bf16_t* ws_t = (bf16_t*)(ws + WS_WS); bf16_t* wg_t = (bf16_t*)(ws + WS_WG);
    bf16_t* pup_t = (bf16_t*)(ws + WS_PUP); bf16_t* lora_t = (bf16_t*)(ws + WS_LORA); bf16_t* pb = (bf16_t*)(ws + WS_PB);
    bf16_t* xb = (bf16_t*)(ws + WS_XB); bf16_t* ymix = xb; bf16_t* pu = xb;
    bf16_t* zr = (bf16_t*)(ws + WS_ZR); bf16_t* law = (bf16_t*)(ws + WS_LAW); bf16_t* hb = zr; bf16_t* alora = (bf16_t*)(ws + WS_ALORA);
    bf16_t* za = (bf16_t*)(ws + WS_ZA); unsigned char* uq = (unsigned char*)(ws + WS_UQ); unsigned char* vq = (unsigned char*)(ws + WS_VQ);
    float* su = (float*)(ws + WS_RS1 + 128 * 1024); float* sv = (float*)(ws + WS_RS1 + 192 * 1024);
    float* sbuf = (float*)(ws + WS_S); bf16_t* h2b = (bf16_t*)(ws + 406 * MiB); bf16_t* h2q = (bf16_t*)(ws + 470 * MiB);
    int* eidx = (int*)(ws + WS_EIDX); float* gates = (float*)(ws + WS_GATES);
    const ScanBufs sbufs{(bf16_t*)(ws + WS_ZA), (bf16_t*)(ws + WS_ZA + 32 * MiB), (bf16_t*)(ws + WS_ZA + 64 * MiB), (bf16_t*)(ws + WS_YH), nullptr, (float*)(ws + WS_BONUS)};
    float* cm_in = (float*)(ws + OFF_CM_IN); float* cm_g = (float*)(ws + OFF_CM_G);
    float* ss2 = (float*)(ws + OFF_SS2); float* ss4 = (float*)(ws + OFF_SS4); float* rs1 = (float*)(ws + WS_RS1); float* rs3 = (float*)(ws + WS_RS3);

    PHREP(0) {
        P0Args a{x, args.in[1], args.in[2], args.in[3], args.in[5], args.in[7], args.in[9], args.in[16], args.in[17], args.in[18], args.in[19], args.in[22], args.in[23], args.in[24],
                 win_t, wout_t, ws_t, wg_t, pup_t, lora_t, xb, pb, rs1, cm_in, cm_g};
        p0_prologue<0>(lds, a, G, bid);
    }
    SEAM(0);
    PHREP(1) {
        P0Args a{x, args.in[1], args.in[2], args.in[3], args.in[5], args.in[7], args.in[9], args.in[16], args.in[17], args.in[18], args.in[19], args.in[22], args.in[23], args.in[24],
                 win_t, wout_t, ws_t, wg_t, pup_t, lora_t, xb, pb, rs1, cm_in, cm_g};
        p0_prologue<2>(lds, a, G, bid);
    }
    SEAM(1);
    PHREP(2) {
        pg8::Gemm g{xb, win_t, M, INC, D / 2, D / 2}; pg8::StaticOrder S; S.init(M, INC, G, bid);
        EpiZ E{zr, za, rs1, cm_in};
        pg8::gemm_phase<EpiZ, pg8::StaticOrder, true, true, true>(lds, g, S, E);
    }
    SEAM(2);
    PHREP(3) { p2_alora(zr, args.in[4], alora, G, bid); attn_phase(lds, za, args.in[15], ymix, G, bid); }
    SEAM(3);
    PHREP(4) {
        int kq = LORA_K; asm volatile("" : "+s"(kq));
        pg8::Gemm g{alora, lora_t, M, LORA_N, kq, LORA_K}; pg8::StaticOrder S; S.init(M, LORA_N, G, bid);
        EpiLora E{law, ymix, args.in[6], args.in[8]};
        pg8::gemm_phase<EpiLora, pg8::StaticOrder, true, true>(lds, g, S, E);
    }
    if (IN(4) && IN(6)) xcd_barrier(bar);
    PHREP(6) { ScanArgs a{zr, law, args.in[4], args.in[10], args.in[11], args.in[12], args.in[13], args.in[14], ymix, nullptr}; scan_sa(lds, a, sbufs, G, bid); }
    SEAM(6);
    PHREP(7) {
        constexpr int NCH_ = BATCH * NH;
        if (G > NCH_) {
            if (bid < NCH_) scan_sb(lds, sbufs, NCH_, bid);
            else {
                P0Args a{x, args.in[1], args.in[2], args.in[3], args.in[5], args.in[7], args.in[9], args.in[16], args.in[17], args.in[18], args.in[19], args.in[22], args.in[23], args.in[24],
                         win_t, wout_t, ws_t, wg_t, pup_t, lora_t, xb, pb, rs1, cm_in, cm_g};
                p0_prologue<1>(lds, a, G - NCH_, bid - NCH_);
                quant_u4(args.in[20], uq, su, G - NCH_, bid - NCH_);
                quant_u4(args.in[21], vq, sv, G - NCH_, bid - NCH_);
            }
        } else {
            scan_sb(lds, sbufs, G, bid);
            P0Args a{x, args.in[1], args.in[2], args.in[3], args.in[5], args.in[7], args.in[9], args.in[16], args.in[17], args.in[18], args.in[19], args.in[22], args.in[23], args.in[24],
                     win_t, wout_t, ws_t, wg_t, pup_t, lora_t, xb, pb, rs1, cm_in, cm_g};
            __syncthreads();
            p0_prologue<1>(lds, a, G, bid);
            quant_u4(args.in[20], uq, su, G, bid);
            quant_u4(args.in[21], vq, sv, G, bid);
        }
    }
    SEAM(7);
    PHREP(8) { ScanArgs a{zr, law, args.in[4], args.in[10], args.in[11], args.in[12], args.in[13], args.in[14], ymix, nullptr}; scan_sc(lds, a, sbufs, G, bid); }
    SEAM(8);
    PHREP(9) {
        pg8::Gemm g{ymix, wout_t, M, D, D, D}; pg8::StaticOrder S; S.init(M, D, G, bid);
        EpiRes1 E{x, hb, ss2};
        pg8::gemm_phase<EpiRes1, pg8::StaticOrder, true, true>(lds, g, S, E);
    }
    SEAM(9);
    PHREP(10) {
        pg8::Gemm g{hb, ws_t, M, D, D, D}; pg8::StaticOrder S; S.init(M, D, G, bid);
        EpiS E{sbuf, ss2};
        pg8::gemm_phase<EpiS, pg8::StaticOrder, true, true>(lds, g, S, E);
    }
    SEAM(10);
    PHREP(11) { topk_phase(lds, sbuf, eidx, gates, G, bid);
        if (G == M * PH / 512) { __syncthreads(); GatherArgs a{hb, h2b, ss2, args.in[17], uq, vq, su, sv, eidx, gates, h2q, rs3}; gather_phase<true>(a, G, bid); } }
    SEAM(11);
    PHREP(12) { if (G != M * PH / 512) { GatherArgs a{hb, h2b, ss2, args.in[17], uq, vq, su, sv, eidx, gates, h2q, rs3}; gather_phase<false>(a, G, bid); } }
    if (G != M * PH / 512) SEAM(12);
    PHREP(13) {
        int kq = PLE; asm volatile("" : "+s"(kq));
        pg8::Gemm g{pb, pup_t, M, D, kq, PLE}; pg8::StaticOrder S; S.init(M, D, G, bid);
        EpiBf E{pu, D};
        pg8::gemm_phase<EpiBf, pg8::StaticOrder, true, true>(lds, g, S, E);
    }
    SEAM(13);
    PHREP(14) {
        pg8::Gemm g{h2q, wg_t, M, D, D / 2, D / 2}; pg8::StaticOrder S; S.init(M, D, G, bid);
        EpiGate E{h2b, pu, rs3, ss4, cm_g};
        pg8::gemm_phase<EpiGate, pg8::StaticOrder, true, true, true>(lds, g, S, E);
    }
    SEAM(14);
    PHREP(15) final_phase(out, pu, ss4, args.in[25], G, bid, (const unsigned*)(ctl + DBG_WORD));
#undef IN
#undef SEAM
}

extern "C" void kernel_launch(void* const* d_in, const int* in_sizes, int n_in, void* d_out, int out_size, void* d_ws, size_t ws_size, hipStream_t stream) {
    static int grid = 0;
    if (grid == 0) {
        if (n_in != 26 || out_size != M * D || ws_size < WS_END) { fprintf(stderr, "kernel_launch: unexpected shapes n_in %d out %d ws %zu\n", n_in, out_size, ws_size); grid = -1; return; }
        int dev = 0, cus = 0;
        if (hipGetDevice(&dev) != hipSuccess || hipDeviceGetAttribute(&cus, hipDeviceAttributeMultiprocessorCount, dev) != hipSuccess) { grid = -1; return; }
        if (hipFuncSetAttribute((const void*)mk_fwd, hipFuncAttributeMaxDynamicSharedMemorySize, LDS_BYTES) != hipSuccess) { fprintf(stderr, "kernel_launch: hipFuncSetAttribute failed\n"); grid = -1; return; }
        int per_cu = 0;
        (void)hipOccupancyMaxActiveBlocksPerMultiprocessor(&per_cu, (const void*)mk_fwd, NWAVES * 64, LDS_BYTES);
        (void)hipGetLastError();
        grid = cus;
    }
    if (grid < 0) return;
    (void)hipMemsetAsync((char*)d_ws + WS_CTL, 0, CTL_ZERO_BYTES, stream);
    Args a{};
    for (int i = 0; i < 26; ++i) a.in[i] = (const float*)d_in[i];
    a.out = (float*)d_out; a.ws = (unsigned char*)d_ws;
    if (MK_N_LAUNCHES == 1) { a.ph_lo = 0; a.ph_hi = N_PHASES; hipLaunchKernelGGL(mk_fwd, dim3(grid), dim3(NWAVES * 64), LDS_BYTES, stream, a); }
    else for (int p = 0; p < N_PHASES; ++p) { a.ph_lo = p; a.ph_hi = p + 1; hipLaunchKernelGGL(mk_fwd, dim3(grid), dim3(NWAVES * 64), LDS_BYTES, stream, a); }
}
```

```cpp
#include <hip/hip_runtime.h>
#include <cstdio>
#include <cstdint>

#define GAS __attribute__((address_space(1)))
#define LAS __attribute__((address_space(3)))
#define PG8_LAS __attribute__((address_space(3)))
typedef unsigned short bf16_t;
typedef short bf16x8 __attribute__((ext_vector_type(8)));
typedef float f32x4 __attribute__((ext_vector_type(4)));
typedef float f32x2 __attribute__((ext_vector_type(2)));
typedef unsigned u32x4 __attribute__((ext_vector_type(4)));
typedef unsigned u32x2 __attribute__((ext_vector_type(2)));
typedef short s16x4 __attribute__((ext_vector_type(4)));

constexpr int BATCH = 2, T = 8192, D = 2048, M = BATCH * T;
constexpr int RW = 1024, AW = 1024, HD = 64, NH = 16;
constexpr int RC = 3328, INC = 6400, ACOLS = 3072;
constexpr int LORA_K = 256, LORA_N = 3072;
constexpr int PH = 8, NKEYS = 128, NEXP = 16384, TOPK = 16, PLE = 256;
constexpr float NORM_EPS = 1e-6f, LNX_EPS = 64e-5f;

namespace pg8 {
constexpr int BM = 256, BK = 64, HALF = 128, HTB = HALF * BK * 2  , STAGE_BYTES = 8 * HTB, NXCD = 8, WGM = 4;
__host__ __device__ __forceinline__ int lds_byte(int r, int c) { const int st = (r >> 4) * 2 + (c >> 5), rr = r & 15, cc = c & 31, ob = rr * 64 + cc * 2; return st * 1024 + (ob ^ (((ob >> 9) & 1) << 5)); }
__host__ __device__ __forceinline__ void stage_rc(int b, int& R, int& C) { const int st = b / 1024, sb = b % 1024, swz = sb ^ (((sb >> 9) & 1) << 5); R = (st >> 1) * 16 + swz / 64; C = (st & 1) * 32 + (swz % 64) / 2; }
__host__ __device__ __forceinline__ int perm32(int rho) { const int n = rho >> 4, i = rho & 15; return 8 * (i >> 2) + 4 * n + (i & 3); }

struct Unit { int pm, pn; };
struct Gemm { const bf16_t* A; const bf16_t* Bt; int M, N, K, lda; };

struct StaticOrder {
    int nM, nN, nwg, G, c, wgm;
    __host__ __device__ void init(int M, int N, int G_, int c_, int wgm_ = WGM) { nM = M / BM; nN = N / BM; nwg = nM * nN; G = G_; c = c_; wgm = wgm_; }
    __host__ __device__ bool next(int i, Unit& u) const {
        const long L = (long)i * G + c; if (L >= nwg) return false;
        int wgid = (int)L; { const int q = nwg / NXCD, r = nwg % NXCD, xcd = wgid % NXCD, off = wgid / NXCD; wgid = (xcd < r ? xcd * (q + 1) : r * (q + 1) + (xcd - r) * q) + off; }
        const int nig = wgm * nN, gid = wgid / nig, fm = gid * wgm, gsz = (nM - fm) < wgm ? (nM - fm) : wgm;
        u.pm = fm + ((wgid % nig) % gsz); u.pn = (wgid % nig) / gsz; return true;
    }
    __device__ __forceinline__ void a_ready(const Unit&) const {}
    __device__ __forceinline__ void done(const Unit&) const {}
};
__device__ __forceinline__ unsigned cvt_pk_bf16(float lo, float hi) { unsigned r; asm volatile("v_cvt_pk_bf16_f32 %0, %1, %2" : "=v"(r) : "v"(lo), "v"(hi)); return r; }

typedef int i32x4 __attribute__((ext_vector_type(4)));
template <class Epi, class Sched, bool ALIGN_EPI = false, bool SP2 = false, bool I8 = false>
__device__ __forceinline__ void gemm_phase(PG8_LAS unsigned char* lds, const Gemm g, const Sched& S, const Epi& E) {
    int tid = threadIdx.x; asm volatile("" : "+v"(tid));
    const int wid = __builtin_amdgcn_readfirstlane(tid >> 6), lane = tid & 63, wr = wid >> 2, wc = wid & 3, fr = lane & 15, fq = lane >> 4;
    const int K = g.K, nt = K / BK;
    unsigned voffA[2], voffB[2];
#pragma unroll
    for (int i = 0; i < 2; ++i) { int R, C; stage_rc(tid * 16 + i * 8192, R, C); const int Rb = Epi::PERM ? ((R & ~31) + perm32(R & 31)) : R;
        voffA[i] = (unsigned)(R * g.lda + C) * 2u; voffB[i] = (unsigned)(Rb * K + C) * 2u; }
    const size_t kstep = (size_t)(BK * 2);
    const size_t hstepA = (size_t)HALF * g.lda * 2, hstepB = (size_t)HALF * K * 2;
    const size_t tstepA = 2 * hstepA, tstepB = 2 * hstepB;
    const unsigned ldsw = (unsigned)wid * 1024u;
    const int aoff = lds_byte(wr * 64 + fr, fq * 8), boff = lds_byte(wc * 32 + fr, fq * 8);
#define PG8_SA(b, h) (((b) * 2 + (h)) * HTB)
#define PG8_SB(b, h) ((4 + (b) * 2 + (h)) * HTB)
#define PG8_STAGE(bufoff, gbase, voff) do { _Pragma("unroll") for (int _i = 0; _i < 2; ++_i) \
        __builtin_amdgcn_global_load_lds((const unsigned*)((const char*)(gbase) + (voff)[_i]), (PG8_LAS unsigned*)(lds + (bufoff) + ldsw + _i * 8192), 16, 0, 0); } while (0)
#define PG8_LDA(dst, b, h) do { _Pragma("unroll") for (int m = 0; m < 4; ++m) _Pragma("unroll") for (int k = 0; k < 2; ++k) dst[m][k] = *(const PG8_LAS bf16x8*)(lds + PG8_SA(b, h) + aoff + m * 2048 + k * 1024); } while (0)
#define PG8_LDB(dst, b, h) do { _Pragma("unroll") for (int n = 0; n < 2; ++n) _Pragma("unroll") for (int k = 0; k < 2; ++k) dst[n][k] = *(const PG8_LAS bf16x8*)(lds + PG8_SB(b, h) + boff + n * 2048 + k * 1024); } while (0)
#define PG8_MMA(ai, bj, At, Bt) do { __builtin_amdgcn_s_setprio(1); _Pragma("unroll") for (int m = 0; m < 4; ++m) _Pragma("unroll") for (int n = 0; n < 2; ++n) _Pragma("unroll") for (int k = 0; k < 2; ++k) \
        { if constexpr (I8) acc[ai][bj][m][n] = __builtin_bit_cast(f32x4, __builtin_amdgcn_mfma_i32_16x16x64_i8(__builtin_bit_cast(i32x4, Bt[n][k]), __builtin_bit_cast(i32x4, At[m][k]), __builtin_bit_cast(i32x4, acc[ai][bj][m][n]), 0, 0, 0)); \
          else acc[ai][bj][m][n] = __builtin_amdgcn_mfma_f32_16x16x32_bf16(Bt[n][k], At[m][k], acc[ai][bj][m][n], 0, 0, 0); } __builtin_amdgcn_s_setprio(0); } while (0)
#define PG8_WAIT_V(n) asm volatile("s_waitcnt vmcnt(" #n ")" ::: "memory")
#define PG8_WAIT_L(n) asm volatile("s_waitcnt lgkmcnt(" #n ")" ::: "memory")
#define PG8_BAR __builtin_amdgcn_s_barrier()
#define PG8_SCHED __builtin_amdgcn_sched_barrier(0)
    Unit cur, nxt; int ui = 0;
    if (!S.next(0, cur)) return;
    f32x4 acc[2][2][4][2];
#pragma unroll
    for (int a = 0; a < 2; ++a)
#pragma unroll
        for (int b = 0; b < 2; ++b)
#pragma unroll
            for (int m = 0; m < 4; ++m)
#pragma unroll
                for (int n = 0; n < 2; ++n) acc[a][b][m][n] = (f32x4){0.f, 0.f, 0.f, 0.f};
    bf16x8 At[4][2], B0[2][2], B1[2][2];
    const char* cA = (const char*)g.A + (size_t)cur.pm * tstepA; const char* cB = (const char*)g.Bt + (size_t)cur.pn * tstepB;
    S.a_ready(cur);
    if constexpr (SP2) {
        PG8_STAGE(PG8_SB(0, 0), cB, voffB); PG8_STAGE(PG8_SB(0, 1), cB + hstepB, voffB); PG8_STAGE(PG8_SA(0, 0), cA, voffA); PG8_STAGE(PG8_SA(0, 1), cA + hstepA, voffA);
        if (wr == 1) PG8_BAR;
        PG8_WAIT_V(2); PG8_BAR;
        PG8_STAGE(PG8_SB(1, 0), cB + kstep, voffB); PG8_STAGE(PG8_SA(1, 0), cA + kstep, voffA); PG8_STAGE(PG8_SB(1, 1), cB + hstepB + kstep, voffB);
        PG8_WAIT_V(6); PG8_BAR;
    } else {
        PG8_STAGE(PG8_SB(0, 0), cB, voffB); PG8_STAGE(PG8_SA(0, 0), cA, voffA); PG8_STAGE(PG8_SB(0, 1), cB + hstepB, voffB); PG8_STAGE(PG8_SA(0, 1), cA + hstepA, voffA);
        if (wr == 1) PG8_BAR;
        PG8_WAIT_V(4); PG8_BAR;
        PG8_STAGE(PG8_SB(1, 0), cB + kstep, voffB); PG8_STAGE(PG8_SA(1, 0), cA + kstep, voffA); PG8_STAGE(PG8_SB(1, 1), cB + hstepB + kstep, voffB);
        PG8_WAIT_V(6); PG8_BAR;
    }
    for (;;) {
        const bool has_next = S.next(ui + 1, nxt);
        const char* nA = has_next ? (const char*)g.A + (size_t)nxt.pm * tstepA : cA; const char* nB = has_next ? (const char*)g.Bt + (size_t)nxt.pn * tstepB : cB;
        for (int t = 0; t < nt; t += 2) {
            const bool last = (t == nt - 2);
            const char* a1 = cA + (size_t)(t + 1) * kstep;
            const char* a2 = last ? nA : cA + (size_t)(t + 2) * kstep; const char* b2 = last ? nB : cB + (size_t)(t + 2) * kstep;
            const char* a3 = a2 + kstep; const char* b3 = b2 + kstep;
            if (last && has_next) S.a_ready(nxt);
            if constexpr (SP2) {
            PG8_LDB(B0, 0, 0); PG8_LDB(B1, 0, 1); PG8_SCHED; PG8_LDA(At, 0, 0); PG8_STAGE(PG8_SA(1, 1), a1 + hstepA, voffA);
            PG8_WAIT_V(8); PG8_WAIT_L(0); PG8_BAR; PG8_MMA(0, 0, At, B0); PG8_MMA(0, 1, At, B1); PG8_BAR; PG8_SCHED;
            PG8_LDA(At, 0, 1); PG8_STAGE(PG8_SB(0, 0), b2, voffB); PG8_STAGE(PG8_SB(0, 1), b2 + hstepB, voffB); PG8_STAGE(PG8_SA(0, 0), a2, voffA);
            PG8_WAIT_V(8); PG8_WAIT_L(0); PG8_BAR; PG8_MMA(1, 0, At, B0); PG8_MMA(1, 1, At, B1); PG8_BAR; PG8_SCHED;
            PG8_LDB(B0, 1, 0); PG8_LDB(B1, 1, 1); PG8_SCHED; PG8_LDA(At, 1, 0); PG8_STAGE(PG8_SA(0, 1), a2 + hstepA, voffA);
            PG8_WAIT_V(8); PG8_WAIT_L(0); PG8_BAR; PG8_MMA(0, 0, At, B0); PG8_MMA(0, 1, At, B1); PG8_BAR; PG8_SCHED;
            PG8_LDA(At, 1, 1); PG8_STAGE(PG8_SB(1, 0), b3, voffB); PG8_STAGE(PG8_SB(1, 1), b3 + hstepB, voffB); PG8_STAGE(PG8_SA(1, 0), a3, voffA);
            PG8_WAIT_V(8); PG8_WAIT_L(0); PG8_BAR; PG8_MMA(1, 0, At, B0); PG8_MMA(1, 1, At, B1); PG8_BAR; PG8_SCHED;
            } else {
            PG8_LDB(B0, 0, 0); PG8_SCHED; PG8_LDA(At, 0, 0); PG8_STAGE(PG8_SA(1, 1), a1 + hstepA, voffA);
            PG8_WAIT_L(8); PG8_BAR; PG8_WAIT_L(0); PG8_MMA(0, 0, At, B0); PG8_BAR; PG8_SCHED;
            PG8_LDB(B1, 0, 1); PG8_STAGE(PG8_SB(0, 0), b2, voffB);
            PG8_BAR; PG8_WAIT_L(0); PG8_MMA(0, 1, At, B1); PG8_BAR;
            PG8_LDA(At, 0, 1); PG8_STAGE(PG8_SA(0, 0), a2, voffA);
            PG8_BAR; PG8_WAIT_L(0); PG8_MMA(1, 0, At, B0); PG8_BAR; PG8_SCHED;
            PG8_STAGE(PG8_SB(0, 1), b2 + hstepB, voffB);
            PG8_WAIT_V(6); PG8_BAR; PG8_MMA(1, 1, At, B1); PG8_BAR;
            PG8_LDB(B0, 1, 0); PG8_SCHED; PG8_LDA(At, 1, 0); PG8_STAGE(PG8_SA(0, 1), a2 + hstepA, voffA);
            PG8_WAIT_L(8); PG8_BAR; PG8_WAIT_L(0); PG8_MMA(0, 0, At, B0); PG8_BAR; PG8_SCHED;
            PG8_LDB(B1, 1, 1); PG8_STAGE(PG8_SB(1, 0), b3, voffB);
            PG8_BAR; PG8_WAIT_L(0); PG8_MMA(0, 1, At, B1); PG8_BAR;
            PG8_LDA(At, 1, 1); PG8_STAGE(PG8_SA(1, 0), a3, voffA);
            PG8_BAR; PG8_WAIT_L(0); PG8_MMA(1, 0, At, B0); PG8_BAR; PG8_SCHED;
            PG8_STAGE(PG8_SB(1, 1), b3 + hstepB, voffB);
            PG8_WAIT_V(6); PG8_BAR; PG8_MMA(1, 1, At, B1); PG8_BAR;
            }
        }
        if constexpr (ALIGN_EPI) { if (wr == 0) PG8_BAR; }
        if constexpr (I8) {
#pragma unroll
            for (int a_ = 0; a_ < 2; ++a_)
#pragma unroll
                for (int b_ = 0; b_ < 2; ++b_)
#pragma unroll
                    for (int m_ = 0; m_ < 4; ++m_)
#pragma unroll
                        for (int n_ = 0; n_ < 2; ++n_) { const i32x4 iv = __builtin_bit_cast(i32x4, acc[a_][b_][m_][n_]); acc[a_][b_][m_][n_] = (f32x4){(float)iv[0], (float)iv[1], (float)iv[2], (float)iv[3]}; }
        }
        if constexpr (!Epi::AFTER_DRAIN) { E(acc, cur, wr, wc, fr, fq); S.done(cur); }
        if (!has_next) break;
#pragma unroll
        for (int a = 0; a < 2; ++a)
#pragma unroll
            for (int b = 0; b < 2; ++b)
#pragma unroll
                for (int m = 0; m < 4; ++m)
#pragma unroll
                    for (int n = 0; n < 2; ++n) acc[a][b][m][n] = (f32x4){0.f, 0.f, 0.f, 0.f};
        cur = nxt; cA = nA; cB = nB; ++ui;
        if constexpr (ALIGN_EPI) { if (wr == 1) PG8_BAR; }
    }
    PG8_WAIT_V(0);
    if constexpr (!ALIGN_EPI) { if (wr == 0) PG8_BAR; }
    PG8_BAR;
    if constexpr (Epi::AFTER_DRAIN) { E.fused(acc, cur, wr, wc, fr, fq, lds, wid, lane); S.done(cur); }
#undef PG8_SA
#undef PG8_SB
#undef PG8_STAGE
#undef PG8_LDA
#undef PG8_LDB
#undef PG8_MMA
#undef PG8_WAIT_V
#undef PG8_WAIT_L
#undef PG8_BAR
#undef PG8_SCHED
}
}

constexpr size_t MiB = 1u << 20;
constexpr size_t WS_CTL = 0, CTL_ZERO_BYTES = 1 * MiB;
constexpr size_t OFF_SS2 = 256 * 1024, OFF_SS4 = 320 * 1024;
constexpr size_t OFF_CM_IN = 448 * 1024, OFF_CM_G = 480 * 1024;
constexpr size_t WS_RS1 = 1 * MiB, WS_RS3 = 1 * MiB + 64 * 1024;
constexpr size_t WS_WIN = 2 * MiB, WS_WOUT = 27 * MiB, WS_WS = 35 * MiB, WS_WG = 43 * MiB, WS_PUP = 51 * MiB, WS_LORA = 52 * MiB, WS_PB = 54 * MiB;
constexpr size_t WS_ALORA = 2 * MiB;
constexpr size_t WS_XB = 62 * MiB;
constexpr size_t WS_ZR = 126 * MiB;
constexpr size_t WS_S = 190 * MiB;
constexpr size_t WS_ZA = 230 * MiB;
constexpr size_t WS_UQ = 326 * MiB, WS_VQ = 358 * MiB;
constexpr size_t WS_LAW = 390 * MiB;
constexpr size_t WS_EIDX = 390 * MiB, WS_GATES = 398 * MiB;
constexpr size_t WS_YH = 454 * MiB, WS_BONUS = 486 * MiB;
constexpr size_t WS_END = 512 * MiB;
constexpr int CW_BAR = 4096;

constexpr int WGM_IN = 4;
constexpr int NWAVES = 8;
constexpr int RING_BYTES = 131072;
constexpr int LDSCTL_OFF = RING_BYTES, MISC_OFF = LDSCTL_OFF + 320;
constexpr int LDS_BYTES = 147456;

typedef GAS unsigned gu32;
#define RLX_AGENT __ATOMIC_RELAXED, __HIP_MEMORY_SCOPE_AGENT
#define LDS_WAIT() asm volatile("s_waitcnt lgkmcnt(0)" ::: "memory")
#define VM_WAIT() asm volatile("s_waitcnt vmcnt(0)" ::: "memory")
#define LBAR() do { asm volatile("s_waitcnt lgkmcnt(0)" ::: "memory"); __builtin_amdgcn_s_barrier(); asm volatile("" ::: "memory"); } while (0)
__device__ __forceinline__ unsigned f2bf(float f) { unsigned u = __builtin_bit_cast(unsigned, f); return (u + 0x7fffu + ((u >> 16) & 1u)) >> 16; }
__device__ __forceinline__ unsigned pk2(float lo, float hi) { return f2bf(lo) | (f2bf(hi) << 16); }
__device__ __forceinline__ float bflo(unsigned w) { return __builtin_bit_cast(float, w << 16); }
__device__ __forceinline__ float bfhi(unsigned w) { return __builtin_bit_cast(float, w & 0xffff0000u); }
__device__ __forceinline__ float wave_sum(float v) {
#pragma unroll
    for (int o = 1; o < 64; o <<= 1) v += __shfl_xor(v, o);
    return v;
}
__device__ __forceinline__ float sigmoidf_(float x) { return __builtin_amdgcn_rcpf(1.0f + __expf(-x)); }

#define XB_TMO      128
#define XB_XCNT(j)  (256  + 64 * (j))
#define XB_XSUB(j)  (1280 + 64 * (j))
#define XB_XGEN(j)  (2304 + 64 * (j))
#define XB_TOP      3328
#define XB_TOPGEN   3392
#define XCD_BAR_WORDS 3456
#define XB_SPIN_CAP (1u << 18)

__device__ __forceinline__ unsigned xb_ld(unsigned* p)              { return __hip_atomic_load(p, __ATOMIC_RELAXED, __HIP_MEMORY_SCOPE_AGENT); }
__device__ __forceinline__ unsigned xb_add(unsigned* p, unsigned v) { return __hip_atomic_fetch_add(p, v, __ATOMIC_RELAXED, __HIP_MEMORY_SCOPE_AGENT); }
__device__ __forceinline__ unsigned xb_xcc_id() { return (unsigned)__builtin_amdgcn_s_getreg((3 << 11) | 20) & 0xFu; }
#define XB_SPIN(cond, bar) do { unsigned _sp = 0; while (cond) { __builtin_amdgcn_s_sleep(1); \
    if ((++_sp & 255u) == 0u) { if (xb_ld(&(bar)[XB_TMO])) break; if (_sp > XB_SPIN_CAP) { atomicAdd(&(bar)[XB_TMO], 1u); break; } } } } while (0)

struct XcdBarrier {
    unsigned* bar; unsigned x;
    volatile LAS unsigned* st;
};

__device__ __forceinline__ XcdBarrier xcd_barrier_post(unsigned* bar, volatile LAS unsigned* st) {
    XcdBarrier b; b.bar = bar; b.x = xb_xcc_id(); b.st = st;
    if (threadIdx.x == 0) (void)xb_add(&bar[XB_XCNT(b.x)], 1u);
    return b;
}
__device__ __forceinline__ void xcd_barrier_complete(unsigned* bar, unsigned x, unsigned& nloc, unsigned& nx) {
    const unsigned G = gridDim.x * gridDim.y * gridDim.z;
    unsigned sum, cnt, mine, sp = 0u;
    for (;;) {
        sum = 0u; cnt = 0u; mine = 0u;
#pragma unroll
        for (unsigned j = 0; j < 16; ++j) { const unsigned c = xb_ld(&bar[XB_XCNT(j)]); sum += c; cnt += (c > 0u) ? 1u : 0u; mine = (j == x) ? c : mine; }
        if (sum == G) break;
        __builtin_amdgcn_s_sleep(1);
        if ((++sp & 255u) == 0u) { if (xb_ld(&bar[XB_TMO])) break; if (sp > XB_SPIN_CAP) { atomicAdd(&bar[XB_TMO], 1u); break; } }
    }
    nloc = mine > 0u ? mine : 1u; nx = cnt > 0u ? cnt : 1u;
}

__device__ __forceinline__ void xcd_barrier(const XcdBarrier& b) {
    asm volatile("s_waitcnt vmcnt(0)" ::: "memory");
    __syncthreads();
    if (threadIdx.x == 0) {
        unsigned* bar = b.bar;
        __builtin_amdgcn_s_waitcnt(0);
        unsigned nloc = b.st[0], nx = b.st[1];
        if (nloc == 0u) { xcd_barrier_complete(bar, b.x, nloc, nx); b.st[0] = nloc; b.st[1] = nx; }
        const unsigned old = xb_add(&bar[XB_XSUB(b.x)], 1u);
        const unsigned gen = old / nloc;
        if (old + 1u == (gen + 1u) * nloc) {
            __builtin_amdgcn_fence(__ATOMIC_RELEASE, "agent");
            asm volatile("s_waitcnt vmcnt(0)" ::: "memory");
            const unsigned og = xb_add(&bar[XB_TOP], 1u);
            const unsigned tg = og / nx;
            if (og + 1u == (tg + 1u) * nx) xb_add(&bar[XB_TOPGEN], 1u);
            else XB_SPIN(xb_ld(&bar[XB_TOPGEN]) == tg, bar);
            __builtin_amdgcn_fence(__ATOMIC_ACQUIRE, "agent");
            xb_add(&bar[XB_XGEN(b.x)], 1u);
            asm volatile("s_waitcnt vmcnt(0)" ::: "memory");
        } else {
            XB_SPIN(xb_ld(&bar[XB_XGEN(b.x)]) == gen, bar);
            __builtin_amdgcn_fence(__ATOMIC_ACQUIRE, "agent");
            asm volatile("s_waitcnt vmcnt(0)" ::: "memory");
        }
    }
    __syncthreads();
}


__device__ __forceinline__ void p0_transpose_item(const float* W, int K, int N, bf16_t* WT, const float* ksc, LAS float* scr, int item, int lane) {
    const int nblk = N / 32, kb = item / nblk, nb = item % nblk, k0 = 64 * kb, n0 = 32 * nb;
#pragma unroll 8
    for (int i = 0; i < 32; ++i) { const int kk = 2 * i + (lane >> 5); const float sc = ksc ? ksc[k0 + kk] : 1.0f; scr[kk * 33 + (lane & 31)] = W[(size_t)(k0 + kk) * N + n0 + (lane & 31)] * sc; }
    LDS_WAIT(); asm volatile("" ::: "memory");
    const int c = lane & 7;
#pragma unroll
    for (int j = 0; j < 4; ++j) { const int n = (lane >> 3) + 8 * j; const LAS float* s = scr + (8 * c) * 33 + n;
        u32x4 o; o.x = pk2(s[0 * 33], s[1 * 33]); o.y = pk2(s[2 * 33], s[3 * 33]); o.z = pk2(s[4 * 33], s[5 * 33]); o.w = pk2(s[6 * 33], s[7 * 33]);
        *(u32x4*)(WT + (size_t)(n0 + n) * K + k0 + 8 * c) = o; }
    LDS_WAIT(); asm volatile("" ::: "memory");
}

__device__ __forceinline__ void p0_qtranspose_item(const float* W, int K, int N, unsigned char* WT, const float* ksc, const float* cmax, LAS float* scr, int item, int lane) {
    const int nblk = N / 32, kb = item / nblk, nb = item % nblk, k0 = 64 * kb, n0 = 32 * nb;
#pragma unroll 8
    for (int i = 0; i < 32; ++i) { const int kk = 2 * i + (lane >> 5); scr[kk * 33 + (lane & 31)] = W[(size_t)(k0 + kk) * N + n0 + (lane & 31)] * ksc[k0 + kk]; }
    LDS_WAIT(); asm volatile("" ::: "memory");
    const int c = lane & 7;
#pragma unroll
    for (int j = 0; j < 4; ++j) { const int n = (lane >> 3) + 8 * j; const LAS float* sp = scr + (8 * c) * 33 + n;
        const float inv = 127.0f / fmaxf(cmax[n0 + n], 1e-30f);
        u32x2 o;
        o.x = ((unsigned)__float2int_rn(sp[0 * 33] * inv) & 0xffu) | (((unsigned)__float2int_rn(sp[1 * 33] * inv) & 0xffu) << 8) | (((unsigned)__float2int_rn(sp[2 * 33] * inv) & 0xffu) << 16) | ((unsigned)__float2int_rn(sp[3 * 33] * inv) << 24);
        o.y = ((unsigned)__float2int_rn(sp[4 * 33] * inv) & 0xffu) | (((unsigned)__float2int_rn(sp[5 * 33] * inv) & 0xffu) << 8) | (((unsigned)__float2int_rn(sp[6 * 33] * inv) & 0xffu) << 16) | ((unsigned)__float2int_rn(sp[7 * 33] * inv) << 24);
        *(u32x2*)(WT + (size_t)(n0 + n) * K + k0 + 8 * c) = o; }
    LDS_WAIT(); asm volatile("" ::: "memory");
}
__device__ __forceinline__ void p0_colmax(const float* W, int K, int N, const float* ksc, float* cmax, int gt, int NGT) {
    constexpr int KSEG = 32;
    for (int idx = gt; idx < N * (K / KSEG); idx += NGT) {
        const int n = idx % N, ks = idx / N; float mx = 0.f;
        for (int k = ks * KSEG; k < (ks + 1) * KSEG; ++k) mx = fmaxf(mx, fabsf(W[(size_t)k * N + n] * ksc[k]));
        atomicMax((int*)cmax + n, __float_as_int(mx));
    }
}
struct P0Args { const float *x, *p, *g1, *w_in, *decay_up, *iclr_up, *gate_up, *w_out, *g2, *wq, *sk, *g3, *wg, *ple_up;
                bf16_t *win_t, *wout_t, *ws_t, *wg_t, *pup_t, *lora_t, *xb, *pb; float* rs1; float* cm_in; float* cm_g; };

#ifndef P0_PROBE
#define P0_PROBE 0
#endif
template <int PART> __device__ __forceinline__ void p0_prologue(LAS unsigned char* lds, const P0Args& a, int G, int bid) {
    const int tid = threadIdx.x, lane = tid & 63, wave = __builtin_amdgcn_readfirstlane(tid >> 6);
    const int gw = bid * NWAVES + wave, NGW = G * NWAVES;
    const int gt = bid * 512 + tid, NGT = G * 512;
    if (PART == 1) {
        LAS float* skl = (LAS float*)lds; LAS float* wql = (LAS float*)(lds + 128 * 129 * 4);
        for (int rp_ = 0; rp_ < (P0_PROBE == 1 ? 2 : 1); ++rp_)
        for (int item = bid; item < 512; item += G) {
            const int hi = item >> 5, k0 = (item & 31) * 64;
            __syncthreads();
            for (int idx = tid; idx < 128 * 128; idx += 512) { const int n = idx >> 7, d = idx & 127; skl[n * 129 + d] = a.sk[(size_t)hi * 16384 + idx]; }
            for (int idx = tid; idx < 64 * 128; idx += 512) { const int k = idx >> 7, d = idx & 127; wql[d * 68 + k] = a.wq[(size_t)(k0 + k) * 2048 + hi * 128 + d]; }
            __syncthreads();
            const int nq = tid & 31, kq = tid >> 5;
            float acc[4][4];
#pragma unroll
            for (int j = 0; j < 4; ++j)
#pragma unroll
                for (int c = 0; c < 4; ++c) acc[j][c] = 0.f;
#pragma unroll 4
            for (int d = 0; d < 128; ++d) {
                const f32x4 wv = *(const LAS f32x4*)(wql + d * 68 + 4 * kq);
#pragma unroll
                for (int j = 0; j < 4; ++j) { const float s = skl[(nq + 32 * j) * 129 + d];
#pragma unroll
                    for (int c = 0; c < 4; ++c) acc[j][c] += s * wv[c]; }
            }
            const f32x4 gg = *(const f32x4*)(a.g2 + k0 + 4 * kq);
#pragma unroll
            for (int j = 0; j < 4; ++j) {
                u32x2 o; o.x = pk2(acc[j][0] * gg[0], acc[j][1] * gg[1]); o.y = pk2(acc[j][2] * gg[2], acc[j][3] * gg[3]);
                *(u32x2*)(a.ws_t + (size_t)(hi * 128 + nq + 32 * j) * 2048 + k0 + 4 * kq) = o;
            }
        }
        __syncthreads();
    }
    {
        LAS float* scr = (LAS float*)(lds + wave * 16384);
        constexpr int I_IN = (D / 64) * (INC / 32), I_SQ = (D / 64) * (D / 32), I_PU = (PLE / 64) * (D / 32);
        constexpr int NITEMS = I_IN + 2 * I_SQ + I_PU;
        if (PART == 0) { p0_colmax(a.w_in, D, INC, a.g1, a.cm_in, gt, NGT); p0_colmax(a.wg, D, D, a.g3, a.cm_g, gt, NGT); }
        if (PART != 0) for (int it = (PART == 2 ? 0 : I_IN) + gw; it < (PART == 2 ? I_IN : NITEMS); it += NGW) {
            int r = it;
            if (r < I_IN) { p0_qtranspose_item(a.w_in, D, INC, (unsigned char*)a.win_t, a.g1, a.cm_in, scr, r, lane); continue; } r -= I_IN;
            if (r < I_SQ) { p0_transpose_item(a.w_out, D, D, a.wout_t, nullptr, scr, r, lane); continue; } r -= I_SQ;
            if (r < I_SQ) { p0_qtranspose_item(a.wg, D, D, (unsigned char*)a.wg_t, a.g3, a.cm_g, scr, r, lane); continue; } r -= I_SQ;
            p0_transpose_item(a.ple_up, PLE, D, a.pup_t, nullptr, scr, r, lane);
        }
    }
    if (PART == 0) for (int idx = gt; idx < LORA_N * LORA_K; idx += NGT) {
        const int n = idx >> 8, k = idx & 255; float v = 0.f;
        if (n < 1024) { if (k < 64) v = a.decay_up[k * 1024 + n]; }
        else if (n < 2048) { if (k >= 64 && k < 128) v = a.iclr_up[(k - 64) * 1024 + (n - 1024)]; }
        else { if (k >= 128) v = a.gate_up[(k - 128) * 1024 + (n - 2048)]; }
        a.lora_t[idx] = (bf16_t)f2bf(v);
    }
    if (PART == 0) for (int m = gw; m < M; m += NGW) {
        const f32x4* xr = (const f32x4*)(a.x + (size_t)m * D) + lane;
        f32x4 v[8]; float sq = 0.f, mx = 0.f;
#pragma unroll
        for (int j = 0; j < 8; ++j) { v[j] = xr[64 * j]; sq += (v[j].x * v[j].x + v[j].y * v[j].y) + (v[j].z * v[j].z + v[j].w * v[j].w); mx = fmaxf(mx, fmaxf(fmaxf(fabsf(v[j].x), fabsf(v[j].y)), fmaxf(fabsf(v[j].z), fabsf(v[j].w)))); }
        sq = wave_sum(sq);
#pragma unroll
        for (int o = 1; o < 64; o <<= 1) mx = fmaxf(mx, __shfl_xor(mx, o));
        const float step = fmaxf(mx, 1e-30f) * (1.0f / 127.0f), inv = 1.0f / step;
        if (lane == 0) a.rs1[m] = step / sqrtf(sq * (1.0f / D) + NORM_EPS);
        unsigned* o4 = (unsigned*)((unsigned char*)a.xb + (size_t)m * D) + lane;
#pragma unroll
        for (int j = 0; j < 8; ++j) o4[64 * j] = ((unsigned)__float2int_rn(v[j].x * inv) & 0xffu) | (((unsigned)__float2int_rn(v[j].y * inv) & 0xffu) << 8) | (((unsigned)__float2int_rn(v[j].z * inv) & 0xffu) << 16) | ((unsigned)__float2int_rn(v[j].w * inv) << 24);
    }
    if (PART == 1) for (int idx = gt; idx < M * PLE / 8; idx += NGT) {
        const f32x4 v0 = *((const f32x4*)a.p + 2 * (size_t)idx), v1 = *((const f32x4*)a.p + 2 * (size_t)idx + 1);
        u32x4 o; o.x = pk2(v0.x, v0.y); o.y = pk2(v0.z, v0.w); o.z = pk2(v1.x, v1.y); o.w = pk2(v1.z, v1.w);
        *((u32x4*)a.pb + idx) = o;
    }
}

__device__ __forceinline__ void cvt_stream(const float* src, bf16_t* dst, size_t n8, int G, int bid) {
    for (size_t idx = (size_t)bid * 512 + threadIdx.x; idx < n8; idx += (size_t)G * 512) {
        const f32x4 v0 = *((const f32x4*)src + 2 * idx), v1 = *((const f32x4*)src + 2 * idx + 1);
        u32x4 o; o.x = pk2(v0.x, v0.y); o.y = pk2(v0.z, v0.w); o.z = pk2(v1.x, v1.y); o.w = pk2(v1.z, v1.w);
        *((u32x4*)dst + idx) = o;
    }
}


template <bool SIGNED> __device__ __forceinline__ void quant_rows(const float* src, unsigned char* dst, float* scale, int G, int bid) {
    const int lane = threadIdx.x & 63, wave = __builtin_amdgcn_readfirstlane(threadIdx.x >> 6);
    for (int e = bid * NWAVES + wave; e < NEXP; e += G * NWAVES) {
        const f32x4* r = (const f32x4*)(src + (size_t)e * D);
        f32x4 v[8]; float mx = 0.f;
#pragma unroll
        for (int j = 0; j < 2; ++j)
#pragma unroll
            for (int q = 0; q < 4; ++q) { const f32x4 t = r[j * 256 + lane * 4 + q]; v[j * 4 + q] = t; mx = fmaxf(mx, fmaxf(fmaxf(fabsf(t[0]), fabsf(t[1])), fmaxf(fabsf(t[2]), fabsf(t[3])))); }
#pragma unroll
        for (int o = 1; o < 64; o <<= 1) mx = fmaxf(mx, __shfl_xor(mx, o));
        const float sc = fmaxf(mx, 1e-30f) * (1.0f / 127.0f), inv = 1.0f / sc;
        if (lane == 0) scale[e] = sc;
#pragma unroll
        for (int j = 0; j < 2; ++j) {
            u32x4 o;
#pragma unroll
            for (int q = 0; q < 4; ++q) { const f32x4 t = v[j * 4 + q];
                constexpr int OFFS = SIGNED ? 0 : 128;
                const unsigned b0 = (unsigned)(__float2int_rn(t[0] * inv) + OFFS) & 0xffu, b1 = (unsigned)(__float2int_rn(t[1] * inv) + OFFS) & 0xffu, b2 = (unsigned)(__float2int_rn(t[2] * inv) + OFFS) & 0xffu, b3 = (unsigned)(__float2int_rn(t[3] * inv) + OFFS) & 0xffu;
                o[q] = b0 | (b1 << 8) | (b2 << 16) | (b3 << 24); }
            *(u32x4*)(dst + (size_t)e * D + j * 1024 + lane * 16) = o;
        }
    }
}

__device__ __forceinline__ void p2_alora(const bf16_t* zr, const float* mu, bf16_t* alora, int G, int bid) {
    for (int idx = bid * 512 + threadIdx.x; idx < M * 32; idx += G * 512) {
        const int m = idx >> 5, c8 = idx & 31, t = m & (T - 1), col = 3072 + c8 * 8;
        const u32x4 cur = *(const u32x4*)(zr + (size_t)m * RC + col);
        u32x4 prv = (u32x4){0u, 0u, 0u, 0u};
        if (t > 0) prv = *(const u32x4*)(zr + (size_t)(m - 1) * RC + col);
        const f32x4 mu0 = *(const f32x4*)(mu + col), mu1 = *(const f32x4*)(mu + col + 4);
        float z[8], zp[8], mm[8] = {mu0.x, mu0.y, mu0.z, mu0.w, mu1.x, mu1.y, mu1.z, mu1.w};
        z[0] = bflo(cur.x); z[1] = bfhi(cur.x); z[2] = bflo(cur.y); z[3] = bfhi(cur.y); z[4] = bflo(cur.z); z[5] = bfhi(cur.z); z[6] = bflo(cur.w); z[7] = bfhi(cur.w);
        zp[0] = bflo(prv.x); zp[1] = bfhi(prv.x); zp[2] = bflo(prv.y); zp[3] = bfhi(prv.y); zp[4] = bflo(prv.z); zp[5] = bfhi(prv.z); zp[6] = bflo(prv.w); zp[7] = bfhi(prv.w);
#pragma unroll
        for (int j = 0; j < 8; ++j) { const float v = z[j] + (zp[j] - z[j]) * mm[j];
            const float sg = __builtin_amdgcn_rcpf(1.0f + __expf(c8 < 8 ? -2.0f * v : -v));
            z[j] = (c8 < 8) ? 2.0f * sg - 1.0f : ((c8 >= 16) ? sg : v); }
        u32x4 o; o.x = pk2(z[0], z[1]); o.y = pk2(z[2], z[3]); o.z = pk2(z[4], z[5]); o.w = pk2(z[6], z[7]);
        *(u32x4*)(alora + (size_t)m * LORA_K + c8 * 8) = o;
    }
}

#define EPI_LOOP_BEGIN \
    _Pragma("unroll") for (int ai = 0; ai < 2; ++ai) _Pragma("unroll") for (int m = 0; m < 4; ++m) { const int row = u.pm * 256 + ai * 128 + wr * 64 + m * 16 + fr; \
    _Pragma("unroll") for (int bj = 0; bj < 2; ++bj) { const int ct = bj * 128 + wc * 32 + 8 * fq; const f32x4 v0 = acc[ai][bj][m][0], v1 = acc[ai][bj][m][1];
#define EPI_LOOP_END } }

struct EpiZ {
    static constexpr bool PERM = true, AFTER_DRAIN = false;
    bf16_t* zr; bf16_t* za; const float* rs1; const float* cmax;
    __device__ __forceinline__ void operator()(const f32x4 (&acc)[2][2][4][2], const pg8::Unit& u, int wr, int wc, int fr, int fq) const {
        bf16_t* base; int ld, c0;
        if (u.pn < 13) { base = zr; ld = RC; c0 = u.pn * 256; } else { base = za; ld = ACOLS; c0 = (u.pn - 13) * 256; }
        EPI_LOOP_BEGIN
            const float sc = rs1[row] * (1.0f / 127.0f);
            const f32x4 c0v = *(const f32x4*)(cmax + u.pn * 256 + ct), c1v = *(const f32x4*)(cmax + u.pn * 256 + ct + 4);
            u32x4 w; w.x = pg8::cvt_pk_bf16(v0[0] * sc * c0v[0], v0[1] * sc * c0v[1]); w.y = pg8::cvt_pk_bf16(v0[2] * sc * c0v[2], v0[3] * sc * c0v[3]); w.z = pg8::cvt_pk_bf16(v1[0] * sc * c1v[0], v1[1] * sc * c1v[1]); w.w = pg8::cvt_pk_bf16(v1[2] * sc * c1v[2], v1[3] * sc * c1v[3]);
            *(u32x4*)(base + (size_t)row * ld + c0 + ct) = w;
        EPI_LOOP_END
    }
};
struct EpiLora {
    static constexpr bool PERM = true, AFTER_DRAIN = false;
    bf16_t* law; bf16_t* gdst; const float* w0; const float* a0;
    __device__ __forceinline__ void operator()(const f32x4 (&acc)[2][2][4][2], const pg8::Unit& u, int wr, int wc, int fr, int fq) const {
        const int kind = u.pn >> 2;
        EPI_LOOP_BEGIN
            const int c = u.pn * 256 + ct;
            float v[8] = {v0[0], v0[1], v0[2], v0[3], v1[0], v1[1], v1[2], v1[3]};
            if (kind == 0) {
#pragma unroll
                for (int j = 0; j < 8; ++j) v[j] = -0.6065306597126334f * sigmoidf_(w0[c + j] + v[j]);
            } else if (kind == 1) {
#pragma unroll
                for (int j = 0; j < 8; ++j) v[j] = sigmoidf_(a0[c - 1024 + j] + v[j]);
            }
            u32x4 w; w.x = pg8::cvt_pk_bf16(v[0], v[1]); w.y = pg8::cvt_pk_bf16(v[2], v[3]); w.z = pg8::cvt_pk_bf16(v[4], v[5]); w.w = pg8::cvt_pk_bf16(v[6], v[7]);
            if (kind < 2) *(u32x4*)(law + (size_t)row * 2048 + c) = w; else *(u32x4*)(gdst + (size_t)row * D + (c - 2048)) = w;
        EPI_LOOP_END
    }
};
struct EpiRes1 {
    static constexpr bool PERM = true, AFTER_DRAIN = false;
    const float* x; bf16_t* hb; float* ss;
    __device__ __forceinline__ void operator()(const f32x4 (&acc)[2][2][4][2], const pg8::Unit& u, int wr, int wc, int fr, int fq) const {
        float part[2][4];
#pragma unroll
        for (int i = 0; i < 2; ++i)
#pragma unroll
            for (int j = 0; j < 4; ++j) part[i][j] = 0.f;
        EPI_LOOP_BEGIN
            const size_t o = (size_t)row * D + u.pn * 256 + ct;
            const f32x4 x0 = *(const f32x4*)(x + o), x1 = *(const f32x4*)(x + o + 4);
            const f32x4 h0 = x0 + v0, h1 = x1 + v1;
            u32x4 w; w.x = pg8::cvt_pk_bf16(h0[0], h0[1]); w.y = pg8::cvt_pk_bf16(h0[2], h0[3]); w.z = pg8::cvt_pk_bf16(h1[0], h1[1]); w.w = pg8::cvt_pk_bf16(h1[2], h1[3]);
            *(u32x4*)(hb + o) = w;
            part[ai][m] += (h0[0] * h0[0] + h0[1] * h0[1]) + (h0[2] * h0[2] + h0[3] * h0[3]) + (h1[0] * h1[0] + h1[1] * h1[1]) + (h1[2] * h1[2] + h1[3] * h1[3]);
        EPI_LOOP_END
#pragma unroll
        for (int ai = 0; ai < 2; ++ai)
#pragma unroll
            for (int m = 0; m < 4; ++m) { float p = part[ai][m]; p += __shfl_xor(p, 16); p += __shfl_xor(p, 32);
                if (fq == 0) atomicAdd(ss + u.pm * 256 + ai * 128 + wr * 64 + m * 16 + fr, p); }
    }
};
struct EpiS {
    static constexpr bool PERM = true, AFTER_DRAIN = false;
    float* s; const float* ss;
    __device__ __forceinline__ void operator()(const f32x4 (&acc)[2][2][4][2], const pg8::Unit& u, int wr, int wc, int fr, int fq) const {
        EPI_LOOP_BEGIN
            const float sc = 1.0f / sqrtf(ss[row] * (1.0f / D) + NORM_EPS);
            const size_t o = (size_t)row * D + u.pn * 256 + ct;
            *(f32x4*)(s + o) = v0 * sc; *(f32x4*)(s + o + 4) = v1 * sc;
        EPI_LOOP_END
    }
};
struct EpiBf {
    static constexpr bool PERM = true, AFTER_DRAIN = false;
    bf16_t* o; int ldc;
    __device__ __forceinline__ void operator()(const f32x4 (&acc)[2][2][4][2], const pg8::Unit& u, int wr, int wc, int fr, int fq) const {
        EPI_LOOP_BEGIN
            u32x4 w; w.x = pg8::cvt_pk_bf16(v0[0], v0[1]); w.y = pg8::cvt_pk_bf16(v0[2], v0[3]); w.z = pg8::cvt_pk_bf16(v1[0], v1[1]); w.w = pg8::cvt_pk_bf16(v1[2], v1[3]);
            *(u32x4*)(o + (size_t)row * ldc + u.pn * 256 + ct) = w;
        EPI_LOOP_END
    }
};
struct EpiGate {
    static constexpr bool PERM = true, AFTER_DRAIN = false;
    const bf16_t* h2; bf16_t* pu; const float* rs3; float* ss; const float* cmax;
    __device__ __forceinline__ void operator()(const f32x4 (&acc)[2][2][4][2], const pg8::Unit& u, int wr, int wc, int fr, int fq) const {
        float part[2][4];
#pragma unroll
        for (int i = 0; i < 2; ++i)
#pragma unroll
            for (int j = 0; j < 4; ++j) part[i][j] = 0.f;
        EPI_LOOP_BEGIN
            const size_t o = (size_t)row * D + u.pn * 256 + ct;
            const float sc = rs3[row] * (1.0f / 127.0f);
            const f32x4 c0v = *(const f32x4*)(cmax + u.pn * 256 + ct) * sc, c1v = *(const f32x4*)(cmax + u.pn * 256 + ct + 4) * sc;
            const u32x4 hw = *(const u32x4*)(h2 + o);
            const f32x4 a0 = {bflo(hw.x), bfhi(hw.x), bflo(hw.y), bfhi(hw.y)}, a1 = {bflo(hw.z), bfhi(hw.z), bflo(hw.w), bfhi(hw.w)};
            const u32x4 pw = *(const u32x4*)(pu + o);
            f32x4 h0, h1;
            h0[0] = a0[0] + sigmoidf_(v0[0] * c0v[0]) * bflo(pw.x); h0[1] = a0[1] + sigmoidf_(v0[1] * c0v[1]) * bfhi(pw.x);
            h0[2] = a0[2] + sigmoidf_(v0[2] * c0v[2]) * bflo(pw.y); h0[3] = a0[3] + sigmoidf_(v0[3] * c0v[3]) * bfhi(pw.y);
            h1[0] = a1[0] + sigmoidf_(v1[0] * c1v[0]) * bflo(pw.z); h1[1] = a1[1] + sigmoidf_(v1[1] * c1v[1]) * bfhi(pw.z);
            h1[2] = a1[2] + sigmoidf_(v1[2] * c1v[2]) * bflo(pw.w); h1[3] = a1[3] + sigmoidf_(v1[3] * c1v[3]) * bfhi(pw.w);
            { u32x4 w3; w3.x = pg8::cvt_pk_bf16(h0[0], h0[1]); w3.y = pg8::cvt_pk_bf16(h0[2], h0[3]); w3.z = pg8::cvt_pk_bf16(h1[0], h1[1]); w3.w = pg8::cvt_pk_bf16(h1[2], h1[3]); *(u32x4*)(pu + o) = w3; }
            part[ai][m] += (h0[0] * h0[0] + h0[1] * h0[1]) + (h0[2] * h0[2] + h0[3] * h0[3]) + (h1[0] * h1[0] + h1[1] * h1[1]) + (h1[2] * h1[2] + h1[3] * h1[3]);
        EPI_LOOP_END
#pragma unroll
        for (int ai = 0; ai < 2; ++ai)
#pragma unroll
            for (int m = 0; m < 4; ++m) { float p = part[ai][m]; p += __shfl_xor(p, 16); p += __shfl_xor(p, 32);
                if (fq == 0) atomicAdd(ss + u.pm * 256 + ai * 128 + wr * 64 + m * 16 + fr, p); }
    }
};

typedef short v4i16_t __attribute__((ext_vector_type(4)));
__device__ __forceinline__ s16x4 vtr(const LAS unsigned char* p) { return __builtin_bit_cast(s16x4, __builtin_amdgcn_ds_read_tr16_b64_v4i16((LAS v4i16_t*)p)); }
constexpr int VROW = 144, ATT_SLOT = 64 * VROW;
__device__ __forceinline__ float xmax4(float v) {
    auto a = __builtin_amdgcn_permlane16_swap(__float_as_uint(v), __float_as_uint(v), false, false); v = fmaxf(__uint_as_float(a[0]), __uint_as_float(a[1]));
    auto b = __builtin_amdgcn_permlane32_swap(__float_as_uint(v), __float_as_uint(v), false, false); return fmaxf(__uint_as_float(b[0]), __uint_as_float(b[1]));
}
__device__ __forceinline__ float xsum4(float v) {
    auto a = __builtin_amdgcn_permlane16_swap(__float_as_uint(v), __float_as_uint(v), false, false); v = __uint_as_float(a[0]) + __uint_as_float(a[1]);
    auto b = __builtin_amdgcn_permlane32_swap(__float_as_uint(v), __float_as_uint(v), false, false); return __uint_as_float(b[0]) + __uint_as_float(b[1]);
}
struct AttnW { const LAS float* biasl; int g, i, ql; float bias_far; };
__device__ __forceinline__ void attn_tile2(const LAS unsigned char* kl, const LAS unsigned char* vl, const bf16x8 (&qf)[2][2], const AttnW& c, int delta, float (&m_run)[2], float (&l)[2], f32x4 (&o)[2][4]) {
    constexpr float SC = 0.125f * 1.4426950408889634f;
    f32x4 s[2][4];
    const LAS unsigned char* kb = kl + c.i * VROW + c.g * 16;
#pragma unroll
    for (int t = 0; t < 4; ++t) {
        const bf16x8 k0 = *(const LAS bf16x8*)(kb + t * 16 * VROW), k1 = *(const LAS bf16x8*)(kb + t * 16 * VROW + 64);
#pragma unroll
        for (int q = 0; q < 2; ++q) {
            s[q][t] = __builtin_amdgcn_mfma_f32_16x16x32_bf16(k0, qf[q][0], (f32x4){0.f, 0.f, 0.f, 0.f}, 0, 0, 0);
            s[q][t] = __builtin_amdgcn_mfma_f32_16x16x32_bf16(k1, qf[q][1], s[q][t], 0, 0, 0);
        }
    }
    bf16x8 pb[2][2];
#pragma unroll
    for (int q = 0; q < 2; ++q) {
        float mx = -INFINITY;
        if (delta >= 3) {
#pragma unroll
            for (int t = 0; t < 4; ++t)
#pragma unroll
                for (int r = 0; r < 4; ++r) mx = fmaxf(mx, s[q][t][r]);
            mx = mx * SC + c.bias_far;
        } else {
            const int base = 64 * delta + c.ql + 16 * q + c.i - 4 * c.g;
#pragma unroll
            for (int t = 0; t < 4; ++t)
#pragma unroll
                for (int r = 0; r < 4; ++r) { int dd = base - (16 * t + r); dd = dd > 128 ? 128 : dd; const float v = s[q][t][r] * SC + c.biasl[128 + dd]; s[q][t][r] = v; mx = fmaxf(mx, v); }
        }
        mx = xmax4(mx);
        const float m_new = (mx > m_run[q] + 6.0f) ? mx : m_run[q];
        if (__builtin_amdgcn_ballot_w64(m_new != m_run[q]) != 0ull) {
            const float f = __builtin_amdgcn_exp2f(m_run[q] - m_new);
            l[q] *= f;
#pragma unroll
            for (int dt = 0; dt < 4; ++dt) o[q][dt] = o[q][dt] * f;
        }
        float ps = 0.f;
        if (delta >= 3) {
            const float off = c.bias_far - m_new;
#pragma unroll
            for (int t = 0; t < 4; ++t)
#pragma unroll
                for (int r = 0; r < 4; ++r) { const float pv = __builtin_amdgcn_exp2f(__builtin_fmaf(s[q][t][r], SC, off)); s[q][t][r] = pv; ps += pv; }
        } else {
#pragma unroll
            for (int t = 0; t < 4; ++t)
#pragma unroll
                for (int r = 0; r < 4; ++r) { const float pv = __builtin_amdgcn_exp2f(s[q][t][r] - m_new); s[q][t][r] = pv; ps += pv; }
        }
        l[q] += ps; m_run[q] = m_new;
#pragma unroll
        for (int ks = 0; ks < 2; ++ks) {
            u32x4 wv; wv.x = pg8::cvt_pk_bf16(s[q][2 * ks][0], s[q][2 * ks][1]); wv.y = pg8::cvt_pk_bf16(s[q][2 * ks][2], s[q][2 * ks][3]); wv.z = pg8::cvt_pk_bf16(s[q][2 * ks + 1][0], s[q][2 * ks + 1][1]); wv.w = pg8::cvt_pk_bf16(s[q][2 * ks + 1][2], s[q][2 * ks + 1][3]);
            pb[q][ks] = __builtin_bit_cast(bf16x8, wv);
        }
    }
    const LAS unsigned char* vb = vl + (4 * c.g + (c.i >> 2)) * VROW + 8 * (c.i & 3);
#pragma unroll
    for (int dt = 0; dt < 4; ++dt)
#pragma unroll
        for (int ks = 0; ks < 2; ++ks) {
            const LAS unsigned char* p0 = vb + 32 * ks * VROW + 32 * dt;
            const s16x4 lo = vtr(p0), hi = vtr(p0 + 16 * VROW);
            const bf16x8 af = (bf16x8){lo[0], lo[1], lo[2], lo[3], hi[0], hi[1], hi[2], hi[3]};
            o[0][dt] = __builtin_amdgcn_mfma_f32_16x16x32_bf16(af, pb[0][ks], o[0][dt], 0, 0, 0);
            o[1][dt] = __builtin_amdgcn_mfma_f32_16x16x32_bf16(af, pb[1][ks], o[1][dt], 0, 0, 0);
        }
}
__device__ __forceinline__ void attn_phase(LAS unsigned char* lds, const bf16_t* za, const float* rel_bias, bf16_t* ymix, int G, int bid) {
    const int tid = threadIdx.x, lane = tid & 63, w = __builtin_amdgcn_readfirstlane(tid >> 6), g = lane >> 4, i = lane & 15;
    LAS unsigned char* kring = lds; LAS unsigned char* vring = lds + 3 * ATT_SLOT;
    LAS float* biasl = (LAS float*)(lds + 6 * ATT_SLOT);
    const int skey = tid >> 3, sch = tid & 7;
    const int soff = skey * VROW + sch * 16;
    constexpr int NUNIT = BATCH * NH * 32;
    const int upb = (NUNIT + G - 1) / G;
    for (int unit = bid * upb; unit < (bid + 1) * upb && unit < NUNIT; ++unit) {
        const int bh = unit >> 5, cq = unit & 31, b = bh >> 4, h = bh & 15, c0 = 4 * cq;
        const int jt0 = c0 - 8 < 0 ? 0 : c0 - 8, ntile = c0 + 4 - jt0;
        const bf16_t* zb = za + (size_t)b * T * ACOLS + h * 64;
        const bf16_t* sp = zb + (size_t)(jt0 * 64 + skey) * ACOLS + sch * 8;
        constexpr size_t TSTEP = (size_t)64 * ACOLS;
        __syncthreads();
        if (tid < 257) biasl[tid] = rel_bias[h * 257 + tid] * 1.4426950408889634f;
        u32x4 kr0, vr0, kr1, vr1, kr2, vr2;
        kr0 = *(const u32x4*)(sp + 1024); vr0 = *(const u32x4*)(sp + 2048);
        kr1 = *(const u32x4*)(sp + TSTEP + 1024); vr1 = *(const u32x4*)(sp + TSTEP + 2048);
        kr2 = *(const u32x4*)(sp + 2 * TSTEP + 1024); vr2 = *(const u32x4*)(sp + 2 * TSTEP + 2048);
        const int cw = c0 + (w >> 1);
        AttnW c; c.biasl = biasl; c.g = g; c.i = i; c.ql = (w & 1) * 32;
        bf16x8 qf[2][2];
#pragma unroll
        for (int q = 0; q < 2; ++q) { const size_t tq = (size_t)(cw * 64 + c.ql + 16 * q + i); qf[q][0] = *(const bf16x8*)(zb + tq * ACOLS + g * 8); qf[q][1] = *(const bf16x8*)(zb + tq * ACOLS + 32 + g * 8); }
        *(LAS u32x4*)(kring + soff) = kr0; *(LAS u32x4*)(vring + soff) = vr0;
        float m_run[2] = {-INFINITY, -INFINITY}, l[2] = {0.f, 0.f};
        f32x4 o[2][4];
#pragma unroll
        for (int q = 0; q < 2; ++q)
#pragma unroll
            for (int dt = 0; dt < 4; ++dt) o[q][dt] = (f32x4){0.f, 0.f, 0.f, 0.f};
#define ATT_IT(n, KI, VI, KW, VW, SR, SW) do { \
            LBAR(); \
            if ((n) == 0) c.bias_far = biasl[256]; \
            if ((n) + 3 < ntile) { KI = *(const u32x4*)(sp + (size_t)((n) + 3) * TSTEP + 1024); VI = *(const u32x4*)(sp + (size_t)((n) + 3) * TSTEP + 2048); } \
            { const int jt = jt0 + (n); if (jt >= cw - 8 && jt <= cw) attn_tile2(kring + (SR) * ATT_SLOT, vring + (SR) * ATT_SLOT, qf, c, cw - jt, m_run, l, o); } \
            if ((n) + 1 < ntile) { *(LAS u32x4*)(kring + (SW) * ATT_SLOT + soff) = KW; *(LAS u32x4*)(vring + (SW) * ATT_SLOT + soff) = VW; } } while (0)
        for (int n = 0; n < ntile; n += 3) {
            ATT_IT(n, kr0, vr0, kr1, vr1, 0, 1);
            if (n + 1 < ntile) ATT_IT(n + 1, kr1, vr1, kr2, vr2, 1, 2);
            if (n + 2 < ntile) ATT_IT(n + 2, kr2, vr2, kr0, vr0, 2, 0);
        }
#undef ATT_IT
#pragma unroll
        for (int q = 0; q < 2; ++q) {
            const float il = 1.0f / xsum4(l[q]);
            bf16_t* orow = ymix + ((size_t)b * T + cw * 64 + c.ql + 16 * q + i) * D + 1024 + h * 64;
#pragma unroll
            for (int dt = 0; dt < 4; ++dt) { u32x2 wv; wv.x = pg8::cvt_pk_bf16(o[q][dt][0] * il, o[q][dt][1] * il); wv.y = pg8::cvt_pk_bf16(o[q][dt][2] * il, o[q][dt][3] * il); *(u32x2*)(orow + 16 * dt + 4 * g) = wv; }
        }
    }
}

#define DPPF(v, ctrl) __int_as_float(__builtin_amdgcn_update_dpp(0, __float_as_int(v), (ctrl), 0xF, 0xF, true))
__device__ __forceinline__ float dpp_sum8(float v) {
    v += DPPF(v, 0xB1);
    v += DPPF(v, 0x4E);
    v += DPPF(v, 0x141);
    return v;
}
__device__ __forceinline__ float wave_sum_dpp(float v) {
    v += DPPF(v, 0xB1); v += DPPF(v, 0x4E); v += DPPF(v, 0x141); v += DPPF(v, 0x140);
    v += __int_as_float(__builtin_amdgcn_update_dpp(0, __float_as_int(v), 0x142, 0xA, 0xF, false));
    v += __int_as_float(__builtin_amdgcn_update_dpp(0, __float_as_int(v), 0x143, 0xC, 0xF, false));
    return __int_as_float(__builtin_amdgcn_readlane(__float_as_int(v), 63));
}
__device__ __forceinline__ void wave_sum8(float (&v)[8]) {
#pragma unroll
    for (int e = 0; e < 8; ++e) v[e] += DPPF(v[e], 0xB1);
#pragma unroll
    for (int e = 0; e < 8; ++e) v[e] += DPPF(v[e], 0x4E);
#pragma unroll
    for (int e = 0; e < 8; ++e) v[e] += DPPF(v[e], 0x141);
#pragma unroll
    for (int e = 0; e < 8; ++e) v[e] += DPPF(v[e], 0x140);
#pragma unroll
    for (int e = 0; e < 8; ++e) v[e] += __int_as_float(__builtin_amdgcn_update_dpp(0, __float_as_int(v[e]), 0x142, 0xA, 0xF, false));
#pragma unroll
    for (int e = 0; e < 8; ++e) v[e] += __int_as_float(__builtin_amdgcn_update_dpp(0, __float_as_int(v[e]), 0x143, 0xC, 0xF, false));
#pragma unroll
    for (int e = 0; e < 8; ++e) v[e] = __int_as_float(__builtin_amdgcn_readlane(__float_as_int(v[e]), 63));
}
constexpr int CL = 64, MROW = 144, MSZ = 64 * MROW;
__device__ __forceinline__ bf16x8 frag_row(const LAS unsigned char* img, int row0, int k0, int g, int i) { return *(const LAS bf16x8*)(img + (row0 + i) * MROW + (k0 + 8 * g) * 2); }
__device__ __forceinline__ bf16x8 frag_col(const LAS unsigned char* img, int k0, int col0, int g, int i) {
    const LAS unsigned char* p = img + (k0 + 8 * g + (i >> 2)) * MROW + (col0 + 4 * (i & 3)) * 2;
    const s16x4 lo = vtr(p), hi = vtr(p + 4 * MROW);
    return (bf16x8){lo[0], lo[1], lo[2], lo[3], hi[0], hi[1], hi[2], hi[3]};
}
#define MFMA16(a, b, c) __builtin_amdgcn_mfma_f32_16x16x32_bf16((a), (b), (c), 0, 0, 0)
typedef __bf16 bf16x2_t __attribute__((ext_vector_type(2)));
__device__ __forceinline__ unsigned cvtpk_c(float lo, float hi) { const f32x2 v = {lo, hi}; const bf16x2_t b = __builtin_convertvector(v, bf16x2_t); return __builtin_bit_cast(unsigned, b); }
__device__ __forceinline__ void st_bf16x4(LAS unsigned char* img, int x, int y, const f32x4& v) { u32x2 w; w.x = cvtpk_c(v[0], v[1]); w.y = cvtpk_c(v[2], v[3]); *(LAS u32x2*)(img + x * MROW + y * 2) = w; }

struct ScanArgs { const bf16_t* zr; const bf16_t* law; const float* mu; const float *k_k, *k_a, *r_k, *lnx_g, *lnx_b; bf16_t* ymix; float* pq; };
struct ChunkOut { LAS unsigned char* pm; LAS unsigned char* qm; };
constexpr int L_NT = 0, L_RT = MSZ, L_BH = 2 * MSZ, L_KH = 3 * MSZ, L_BB = 4 * MSZ, L_KB = 5 * MSZ, L_VV = 6 * MSZ, L_ANK = 7 * MSZ, L_ARB = 8 * MSZ, L_ARK = 9 * MSZ;
constexpr int L_ANB = 10 * MSZ, ANBP = 68;
constexpr int L_TOT = L_ANB + 64 * ANBP * 4;
constexpr int DGP = 20;
constexpr int L_DG = L_TOT + 8 * 64 * 4 + 256;
constexpr int L_END = L_DG + 4 * 4 * 16 * DGP * 4;
constexpr int L_TM = L_BH, L_X1 = L_KH, L_WH = L_ANK, L_NH = L_ANB;


#ifndef SCAN_DEBUG
#define SCAN_DEBUG 0
#endif
constexpr int DBG_WORD = 2048;
__device__ __forceinline__ float img_at(const LAS unsigned char* img, int r, int c) { return bflo((unsigned)*(const LAS bf16_t*)(img + r * MROW + c * 2)); }
__device__ __forceinline__ void dbg_flag(unsigned* dbg, bool bad, unsigned bit) { if (bad) atomicOr(dbg, bit); }
__device__ __forceinline__ bool dbg_bad(float got, float ref) { return !(fabsf(got - ref) <= 0.03f * fabsf(ref) + 0.02f); }
__device__ __forceinline__ void fchain(int n, float& c, const f32x4& a, float t0, float t1, float t2, float t3) {
    const float a0 = a[0], a1 = a[1], a2 = a[2], a3 = a[3];
    if (n == 1) asm("v_fma_f32 %0, %1, %2, %0" : "+v"(c) : "v"(a0), "v"(t0));
    else if (n == 2) asm("v_fma_f32 %0, %1, %2, %0\n\tv_fma_f32 %0, %3, %4, %0" : "+v"(c) : "v"(a0), "v"(t0), "v"(a1), "v"(t1));
    else if (n == 3) asm("v_fma_f32 %0, %1, %2, %0\n\tv_fma_f32 %0, %3, %4, %0\n\tv_fma_f32 %0, %5, %6, %0" : "+v"(c) : "v"(a0), "v"(t0), "v"(a1), "v"(t1), "v"(a2), "v"(t2));
    else asm("v_fma_f32 %0, %1, %2, %0\n\tv_fma_f32 %0, %3, %4, %0\n\tv_fma_f32 %0, %5, %6, %0\n\tv_fma_f32 %0, %7, %8, %0" : "+v"(c) : "v"(a0), "v"(t0), "v"(a1), "v"(t1), "v"(a2), "v"(t2), "v"(a3), "v"(t3));
}
__device__ __forceinline__ float mchain(int n, const f32x4& a, float t0, float t1, float t2, float t3) {
    const float a0 = a[0], a1 = a[1], a2 = a[2], a3 = a[3]; float c;
    if (n == 1) asm("v_mul_f32 %0, %1, %2" : "=&v"(c) : "v"(a0), "v"(t0));
    else if (n == 2) asm("v_mul_f32 %0, %1, %2\n\tv_fma_f32 %0, %3, %4, %0" : "=&v"(c) : "v"(a0), "v"(t0), "v"(a1), "v"(t1));
    else if (n == 3) asm("v_mul_f32 %0, %1, %2\n\tv_fma_f32 %0, %3, %4, %0\n\tv_fma_f32 %0, %5, %6, %0" : "=&v"(c) : "v"(a0), "v"(t0), "v"(a1), "v"(t1), "v"(a2), "v"(t2));
    else asm("v_mul_f32 %0, %1, %2\n\tv_fma_f32 %0, %3, %4, %0\n\tv_fma_f32 %0, %5, %6, %0\n\tv_fma_f32 %0, %7, %8, %0" : "=&v"(c) : "v"(a0), "v"(t0), "v"(a1), "v"(t1), "v"(a2), "v"(t2), "v"(a3), "v"(t3));
    return c;
}
__device__ __forceinline__ void oct_fma8(float (&x)[8], float a0, float a1, float a2, float a3, float a4, float a5, float a6, float a7, float t) {
    asm("v_fma_f32 %0, %8, %16, %0\n\tv_fma_f32 %1, %9, %16, %1\n\tv_fma_f32 %2, %10, %16, %2\n\tv_fma_f32 %3, %11, %16, %3\n\tv_fma_f32 %4, %12, %16, %4\n\tv_fma_f32 %5, %13, %16, %5\n\tv_fma_f32 %6, %14, %16, %6\n\tv_fma_f32 %7, %15, %16, %7"
        : "+v"(x[0]), "+v"(x[1]), "+v"(x[2]), "+v"(x[3]), "+v"(x[4]), "+v"(x[5]), "+v"(x[6]), "+v"(x[7])
        : "v"(a0), "v"(a1), "v"(a2), "v"(a3), "v"(a4), "v"(a5), "v"(a6), "v"(a7), "v"(t));
}
__device__ __forceinline__ void oct_mul8(float (&x)[8], float a0, float a1, float a2, float a3, float a4, float a5, float a6, float a7, float t) {
    asm("v_mul_f32 %0, %8, %16\n\tv_mul_f32 %1, %9, %16\n\tv_mul_f32 %2, %10, %16\n\tv_mul_f32 %3, %11, %16\n\tv_mul_f32 %4, %12, %16\n\tv_mul_f32 %5, %13, %16\n\tv_mul_f32 %6, %14, %16\n\tv_mul_f32 %7, %15, %16"
        : "=&v"(x[0]), "=&v"(x[1]), "=&v"(x[2]), "=&v"(x[3]), "=&v"(x[4]), "=&v"(x[5]), "=&v"(x[6]), "=&v"(x[7])
        : "v"(a0), "v"(a1), "v"(a2), "v"(a3), "v"(a4), "v"(a5), "v"(a6), "v"(a7), "v"(t));
}
__device__ __forceinline__ void oct_dpp_sum8(float (&x)[8]) {
    asm("s_nop 1\n\tv_add_f32_dpp %0, %0, %0 quad_perm:[1,0,3,2] row_mask:0xf bank_mask:0xf bound_ctrl:1\n\tv_add_f32_dpp %1, %1, %1 quad_perm:[1,0,3,2] row_mask:0xf bank_mask:0xf bound_ctrl:1\n\tv_add_f32_dpp %2, %2, %2 quad_perm:[1,0,3,2] row_mask:0xf bank_mask:0xf bound_ctrl:1\n\tv_add_f32_dpp %3, %3, %3 quad_perm:[1,0,3,2] row_mask:0xf bank_mask:0xf bound_ctrl:1\n\tv_add_f32_dpp %4, %4, %4 quad_perm:[1,0,3,2] row_mask:0xf bank_mask:0xf bound_ctrl:1\n\tv_add_f32_dpp %5, %5, %5 quad_perm:[1,0,3,2] row_mask:0xf bank_mask:0xf bound_ctrl:1\n\tv_add_f32_dpp %6, %6, %6 quad_perm:[1,0,3,2] row_mask:0xf bank_mask:0xf bound_ctrl:1\n\tv_add_f32_dpp %7, %7, %7 quad_perm:[1,0,3,2] row_mask:0xf bank_mask:0xf bound_ctrl:1\n\tv_add_f32_dpp %0, %0, %0 quad_perm:[2,3,0,1] row_mask:0xf bank_mask:0xf bound_ctrl:1\n\tv_add_f32_dpp %1, %1, %1 quad_perm:[2,3,0,1] row_mask:0xf bank_mask:0xf bound_ctrl:1\n\tv_add_f32_dpp %2, %2, %2 quad_perm:[2,3,0,1] row_mask:0xf bank_mask:0xf bound_ctrl:1\n\tv_add_f32_dpp %3, %3, %3 quad_perm:[2,3,0,1] row_mask:0xf bank_mask:0xf bound_ctrl:1\n\tv_add_f32_dpp %4, %4, %4 quad_perm:[2,3,0,1] row_mask:0xf bank_mask:0xf bound_ctrl:1\n\tv_add_f32_dpp %5, %5, %5 quad_perm:[2,3,0,1] row_mask:0xf bank_mask:0xf bound_ctrl:1\n\tv_add_f32_dpp %6, %6, %6 quad_perm:[2,3,0,1] row_mask:0xf bank_mask:0xf bound_ctrl:1\n\tv_add_f32_dpp %7, %7, %7 quad_perm:[2,3,0,1] row_mask:0xf bank_mask:0xf bound_ctrl:1\n\tv_add_f32_dpp %0, %0, %0 row_half_mirror row_mask:0xf bank_mask:0xf bound_ctrl:1\n\tv_add_f32_dpp %1, %1, %1 row_half_mirror row_mask:0xf bank_mask:0xf bound_ctrl:1\n\tv_add_f32_dpp %2, %2, %2 row_half_mirror row_mask:0xf bank_mask:0xf bound_ctrl:1\n\tv_add_f32_dpp %3, %3, %3 row_half_mirror row_mask:0xf bank_mask:0xf bound_ctrl:1\n\tv_add_f32_dpp %4, %4, %4 row_half_mirror row_mask:0xf bank_mask:0xf bound_ctrl:1\n\tv_add_f32_dpp %5, %5, %5 row_half_mirror row_mask:0xf bank_mask:0xf bound_ctrl:1\n\tv_add_f32_dpp %6, %6, %6 row_half_mirror row_mask:0xf bank_mask:0xf bound_ctrl:1\n\tv_add_f32_dpp %7, %7, %7 row_half_mirror row_mask:0xf bank_mask:0xf bound_ctrl:1"
        : "+v"(x[0]), "+v"(x[1]), "+v"(x[2]), "+v"(x[3]), "+v"(x[4]), "+v"(x[5]), "+v"(x[6]), "+v"(x[7]));
}
__device__ __forceinline__ void oct_col(int n, float& y0, float& y1, float& y2, float& y3, float& y4, float& y5, float& y6, float l0, float l1, float l2, float l3, float l4, float l5, float l6, float xp) {
    if (n == 7) asm("v_fma_f32 %0, %7, %14, %0\n\tv_fma_f32 %1, %8, %14, %1\n\tv_fma_f32 %2, %9, %14, %2\n\tv_fma_f32 %3, %10, %14, %3\n\tv_fma_f32 %4, %11, %14, %4\n\tv_fma_f32 %5, %12, %14, %5\n\tv_fma_f32 %6, %13, %14, %6" : "+v"(y0), "+v"(y1), "+v"(y2), "+v"(y3), "+v"(y4), "+v"(y5), "+v"(y6) : "v"(l0), "v"(l1), "v"(l2), "v"(l3), "v"(l4), "v"(l5), "v"(l6), "v"(xp));
    else if (n == 6) asm("v_fma_f32 %0, %6, %12, %0\n\tv_fma_f32 %1, %7, %12, %1\n\tv_fma_f32 %2, %8, %12, %2\n\tv_fma_f32 %3, %9, %12, %3\n\tv_fma_f32 %4, %10, %12, %4\n\tv_fma_f32 %5, %11, %12, %5" : "+v"(y0), "+v"(y1), "+v"(y2), "+v"(y3), "+v"(y4), "+v"(y5) : "v"(l0), "v"(l1), "v"(l2), "v"(l3), "v"(l4), "v"(l5), "v"(xp));
    else if (n == 5) asm("v_fma_f32 %0, %5, %10, %0\n\tv_fma_f32 %1, %6, %10, %1\n\tv_fma_f32 %2, %7, %10, %2\n\tv_fma_f32 %3, %8, %10, %3\n\tv_fma_f32 %4, %9, %10, %4" : "+v"(y0), "+v"(y1), "+v"(y2), "+v"(y3), "+v"(y4) : "v"(l0), "v"(l1), "v"(l2), "v"(l3), "v"(l4), "v"(xp));
    else if (n == 4) asm("v_fma_f32 %0, %4, %8, %0\n\tv_fma_f32 %1, %5, %8, %1\n\tv_fma_f32 %2, %6, %8, %2\n\tv_fma_f32 %3, %7, %8, %3" : "+v"(y0), "+v"(y1), "+v"(y2), "+v"(y3) : "v"(l0), "v"(l1), "v"(l2), "v"(l3), "v"(xp));
    else if (n == 3) asm("v_fma_f32 %0, %3, %6, %0\n\tv_fma_f32 %1, %4, %6, %1\n\tv_fma_f32 %2, %5, %6, %2" : "+v"(y0), "+v"(y1), "+v"(y2) : "v"(l0), "v"(l1), "v"(l2), "v"(xp));
    else if (n == 2) asm("v_fma_f32 %0, %2, %4, %0\n\tv_fma_f32 %1, %3, %4, %1" : "+v"(y0), "+v"(y1) : "v"(l0), "v"(l1), "v"(xp));
    else if (n == 1) asm("v_fma_f32 %0, %1, %2, %0" : "+v"(y0) : "v"(l0), "v"(xp));
}
struct ChunkRaw { bf16_t r[9], k[9], v[9], lw[8], a[8]; };
__device__ __forceinline__ void chunk_load(ChunkRaw& q, const ScanArgs& a, size_t m0, int h) {
    const int lane = threadIdx.x & 63, w = __builtin_amdgcn_readfirstlane(threadIdx.x >> 6);
    const size_t mb = __builtin_amdgcn_readfirstlane((unsigned)(m0 + 8 * w));
    const bool first = ((mb & (T - 1)) == 0);
#define UPTR(p) asm volatile("" : "+s"(p))
    { const GAS bf16_t* zu = (const GAS bf16_t*)a.zr + (first ? mb : mb - 1) * RC + h * 64; const GAS bf16_t* zv = zu + 2048; UPTR(zu); UPTR(zv);
      q.r[0] = first ? (bf16_t)0 : zu[lane]; q.k[0] = first ? (bf16_t)0 : (zu + 1024)[lane]; q.v[0] = first ? (bf16_t)0 : zv[lane]; }
#pragma unroll
    for (int e = 0; e < 8; ++e) { const size_t m = mb + e; const GAS bf16_t* zu = (const GAS bf16_t*)a.zr + m * RC + h * 64; const GAS bf16_t* zv = zu + 2048; const GAS bf16_t* lu = (const GAS bf16_t*)a.law + m * 2048 + h * 64; UPTR(zu); UPTR(zv); UPTR(lu);
        q.r[e + 1] = zu[lane]; q.k[e + 1] = (zu + 1024)[lane]; q.v[e + 1] = zv[lane];
        q.lw[e] = lu[lane]; q.a[e] = (lu + 1024)[lane]; }
#undef UPTR
}
__device__ __forceinline__ void chunk_build(LAS unsigned char* lds, const ScanArgs& a, const ChunkRaw& raw, int h, float* bonus_out, unsigned* dbg) {
    const int tid = threadIdx.x, lane = tid & 63, w = __builtin_amdgcn_readfirstlane(tid >> 6), g = lane >> 4, i = lane & 15;
    LAS float* tot = (LAS float*)(lds + L_TOT);
#ifndef SA_PROBE
#define SA_PROBE 0
#endif
    for (int rep_ = 0; rep_ < (SA_PROBE == 1 ? 2 : 1); ++rep_) {
        if (rep_) __syncthreads();
        const float kkc = a.k_k[h * 64 + lane], kac = a.k_a[h * 64 + lane], rkc = a.r_k[h * 64 + lane];
        const float mur = a.mu[h * 64 + lane], muk = a.mu[1024 + h * 64 + lane], muv = a.mu[2048 + h * 64 + lane];
        float r[8], kp[8], vv[8], nn[8], bb[8], lw[8], bo8[8], kkr[8], kq[8], aa[8], ss8[8];
#pragma unroll
        for (int e = 0; e < 8; ++e) {
            const float rc = bflo((unsigned)raw.r[e + 1]), kc = bflo((unsigned)raw.k[e + 1]), vc = bflo((unsigned)raw.v[e + 1]);
            r[e] = rc + (bflo((unsigned)raw.r[e]) - rc) * mur; kq[e] = kc + (bflo((unsigned)raw.k[e]) - kc) * muk; vv[e] = vc + (bflo((unsigned)raw.v[e]) - vc) * muv;
            lw[e] = bflo((unsigned)raw.lw[e]); aa[e] = bflo((unsigned)raw.a[e]);
            kkr[e] = kq[e] * kkc; ss8[e] = kkr[e] * kkr[e];
        }
        wave_sum8(ss8);
#pragma unroll
        for (int e = 0; e < 8; ++e) {
            const float kk = kkr[e] * __builtin_amdgcn_rsqf(fmaxf(ss8[e], 1e-24f));
            kp[e] = kq[e] * (1.0f + (aa[e] - 1.0f) * kac); nn[e] = -kk; bb[e] = kk * aa[e];
            bo8[e] = r[e] * kp[e] * rkc;
        }
        wave_sum8(bo8);
        if (bonus_out && lane == 0) {
            *(f32x4*)(bonus_out + 8 * w) = (f32x4){bo8[0], bo8[1], bo8[2], bo8[3]}; *(f32x4*)(bonus_out + 8 * w + 4) = (f32x4){bo8[4], bo8[5], bo8[6], bo8[7]};
        }
        float cl[8]; cl[0] = lw[0];
#pragma unroll
        for (int e = 1; e < 8; ++e) cl[e] = cl[e - 1] + lw[e];
        tot[w * 64 + lane] = cl[7];
        __syncthreads();
        float off = 0.f, cumL = 0.f;
#pragma unroll
        for (int q = 0; q < 8; ++q) { const float tq = tot[q * 64 + lane]; cumL += tq; if (q < w) off += tq; }
        const float eL = __expf(cumL);
        float eGp = __expf(off);
#pragma unroll
        for (int e = 0; e < 8; ++e) {
            const int s = 8 * w + e; const float cum = off + cl[e];
            const float eG = __expf(cum), eGx = eGp, eI = __builtin_amdgcn_rcpf(eG), eB = eL * eI;
            eGp = eG;
            const int o = s * MROW + lane * 2;
            const unsigned p0 = cvtpk_c(nn[e] * eGx, r[e] * eG), p1 = cvtpk_c(bb[e] * eI, kp[e] * eI), p2 = cvtpk_c(bb[e] * eB, kp[e] * eB), p3 = cvtpk_c(vv[e], vv[e]);
            *(LAS bf16_t*)(lds + L_NT + o) = (bf16_t)p0; *(LAS bf16_t*)(lds + L_RT + o) = (bf16_t)(p0 >> 16);
            *(LAS bf16_t*)(lds + L_BH + o) = (bf16_t)p1; *(LAS bf16_t*)(lds + L_KH + o) = (bf16_t)(p1 >> 16);
            *(LAS bf16_t*)(lds + L_BB + o) = (bf16_t)p2; *(LAS bf16_t*)(lds + L_KB + o) = (bf16_t)(p2 >> 16);
            *(LAS bf16_t*)(lds + L_VV + o) = (bf16_t)p3;
        }
        __syncthreads();
        if (w == 0) tot[lane] = eL;
    }
    for (int rep_ = 0; rep_ < (SA_PROBE == 2 ? 2 : 1); ++rep_) {
        LAS float* anb = (LAS float*)(lds + L_ANB);
#pragma unroll
        for (int tt = 0; tt < 2; ++tt) {
            const int t = w + 8 * tt, sb = t >> 2, jb = t & 3, s0 = 16 * sb, j0 = 16 * jb;
            const int sx = s0 + i, jy = j0 + 4 * g;
            f32x4 cnb = {0.f, 0.f, 0.f, 0.f}, cnk = cnb, crb = cnb, crk = cnb;
            if (jb <= sb) {
#pragma unroll
                for (int k0 = 0; k0 < 64; k0 += 32) {
                    const bf16x8 fb = frag_row(lds + L_BH, j0, k0, g, i), fk = frag_row(lds + L_KH, j0, k0, g, i), fn = frag_row(lds + L_NT, s0, k0, g, i), fr = frag_row(lds + L_RT, s0, k0, g, i);
                    cnb = MFMA16(fb, fn, cnb); cnk = MFMA16(fk, fn, cnk); crb = MFMA16(fb, fr, crb); crk = MFMA16(fk, fr, crk);
                }
#pragma unroll
                for (int q = 0; q < 4; ++q) { const int j = jy + q; if (j >= sx) { cnb[q] = 0.f; cnk[q] = 0.f; } if (j > sx) { crb[q] = 0.f; crk[q] = 0.f; } }
            }
            *(LAS f32x4*)(anb + sx * ANBP + jy) = cnb;
            st_bf16x4(lds + L_ANK, sx, jy, cnk); st_bf16x4(lds + L_ARB, sx, jy, crb); st_bf16x4(lds + L_ARK, sx, jy, crk);
        }
    }
    __syncthreads();
    if (w < 4) {
        const LAS float* anb = (const LAS float*)(lds + L_ANB);
        LAS float* dw = (LAS float*)(lds + L_DG) + w * (4 * 16 * DGP);
        {
            const LAS float* lb = anb + (16 * g) * ANBP + 16 * g;
            float x[16];
#pragma unroll
            for (int r = 0; r < 16; ++r) x[r] = (i == r) ? 1.f : 0.f;
#pragma unroll
            for (int R = 0; R < 4; ++R) {
                f32x4 lq[4][4];
#pragma unroll
                for (int rr = 0; rr < 4; ++rr)
#pragma unroll
                    for (int q = 0; q <= R; ++q) if (q < R || rr > 0) lq[rr][q] = *(const LAS f32x4*)(lb + (4 * R + rr) * ANBP + 4 * q);
                asm volatile("" ::: "memory");
#pragma unroll
                for (int rr = 0; rr < 4; ++rr) {
                    const int r = 4 * R + rr;
#pragma unroll
                    for (int q = 0; q < R; ++q) fchain(4, x[r], lq[rr][q], x[4 * q], x[4 * q + 1], x[4 * q + 2], x[4 * q + 3]);
                    if (rr > 0) fchain(rr, x[r], lq[rr][R], x[4 * R], x[4 * R + 1], x[4 * R + 2], x[4 * R + 3]);
                }
            }
#pragma unroll
            for (int r = 0; r < 16; ++r) dw[(g * 16 + r) * DGP + i] = x[r];
            LDS_WAIT();
        }
        f32x4 Tt[4];
#pragma unroll
        for (int I = 0; I < 4; ++I) {
            f32x4 t = {0.f, 0.f, 0.f, 0.f};
            if (I == w) {
#pragma unroll
                for (int r = 0; r < 4; ++r) t[r] = dw[(I * 16 + 4 * g + r) * DGP + i];
            } else if (I > w) {
                f32x4 acc = {0.f, 0.f, 0.f, 0.f};
#pragma unroll
                for (int J = 0; J < I; ++J) {
                    if (J >= w) {
                        const f32x4 av = *(const LAS f32x4*)(anb + (16 * I + i) * ANBP + 16 * J + 4 * g);
#pragma unroll
                        for (int r = 0; r < 4; ++r) acc = __builtin_amdgcn_mfma_f32_16x16x4f32(av[r], Tt[J][r], acc, 0, 0, 0);
                    }
                }
                const f32x4 dv = *(const LAS f32x4*)(dw + (I * 16 + i) * DGP + 4 * g);
#pragma unroll
                for (int r = 0; r < 4; ++r) t = __builtin_amdgcn_mfma_f32_16x16x4f32(dv[r], acc[r], t, 0, 0, 0);
            }
            Tt[I] = t;
            const unsigned p01 = cvtpk_c(t[0], t[1]), p23 = cvtpk_c(t[2], t[3]);
            LAS unsigned char* tp = lds + L_TM + (16 * I + 4 * g) * MROW + (16 * w + i) * 2;
            *(LAS bf16_t*)(tp) = (bf16_t)p01; *(LAS bf16_t*)(tp + MROW) = (bf16_t)(p01 >> 16); *(LAS bf16_t*)(tp + 2 * MROW) = (bf16_t)p23; *(LAS bf16_t*)(tp + 3 * MROW) = (bf16_t)(p23 >> 16);
        }
    } else {
#pragma unroll
        for (int tt = 0; tt < 4; ++tt) {
            const int t = 4 * (w - 4) + tt, x0 = 16 * (t >> 2), y0 = 16 * (t & 3);
            f32x4 c = {0.f, 0.f, 0.f, 0.f};
#pragma unroll
            for (int k0 = 0; k0 < 64; k0 += 32) c = MFMA16(frag_col(lds + L_VV, k0, y0, g, i), frag_row(lds + L_ANK, x0, k0, g, i), c);
            st_bf16x4(lds + L_X1, x0 + i, y0 + 4 * g, c);
        }
    }
    __syncthreads();
    if (SCAN_DEBUG && dbg) {
        const int j = tid >> 3, v0 = (tid & 7) * 8; bool bad = false;
        _Pragma("nounroll") for (int q = 0; q < 8; ++q) { float ref = 0.f; _Pragma("nounroll") for (int jp = 0; jp < 64; ++jp) ref += img_at(lds + L_ANK, j, jp) * img_at(lds + L_VV, jp, v0 + q); bad |= dbg_bad(img_at(lds + L_X1, j, v0 + q), ref); }
        dbg_flag(dbg, bad, 1u);
        __syncthreads();
    }
    for (int rep_ = 0; rep_ < (SA_PROBE == 5 ? 2 : 1); ++rep_) {
#pragma unroll
        for (int tt = 0; tt < 2; ++tt) {
            const int t = w + 8 * tt, x0 = 16 * (t >> 2), y0 = 16 * (t & 3);
            f32x4 cw = {0.f, 0.f, 0.f, 0.f}, cn = cw;
#pragma unroll
            for (int k0 = 0; k0 < 64; k0 += 32) { const bf16x8 ft = frag_row(lds + L_TM, x0, k0, g, i); cw = MFMA16(frag_col(lds + L_X1, k0, y0, g, i), ft, cw); cn = MFMA16(frag_col(lds + L_NT, k0, y0, g, i), ft, cn); }
            st_bf16x4(lds + L_WH, x0 + i, y0 + 4 * g, cw); st_bf16x4(lds + L_NH, x0 + i, y0 + 4 * g, cn);
        }
    }
    __syncthreads();
    if (SCAN_DEBUG && dbg) {
        const int sr = tid >> 3, v0 = (tid & 7) * 8; bool badw = false, badn = false;
        _Pragma("nounroll") for (int q = 0; q < 8; ++q) { float rw = 0.f, rn = 0.f; _Pragma("nounroll") for (int j = 0; j < 64; ++j) { const float tv = img_at(lds + L_TM, sr, j); rw += tv * img_at(lds + L_X1, j, v0 + q); rn += tv * img_at(lds + L_NT, j, v0 + q); }
            badw |= dbg_bad(img_at(lds + L_WH, sr, v0 + q), rw); badn |= dbg_bad(img_at(lds + L_NH, sr, v0 + q), rn); }
        dbg_flag(dbg, badw, 2u); dbg_flag(dbg, badn, 4u);
        __syncthreads();
    }
}
__device__ __forceinline__ void chunk_pq_tile(const LAS unsigned char* lds, int x0, int y0, int g, int i, f32x4& cp, f32x4& cq) {
    cp = (f32x4){0.f, 0.f, 0.f, 0.f}; cq = cp;
#pragma unroll
    for (int k0 = 0; k0 < 64; k0 += 32) {
        const bf16x8 fb = frag_col(lds + L_BB, k0, x0, g, i), fk = frag_col(lds + L_KB, k0, x0, g, i);
        cp = MFMA16(frag_col(lds + L_NH, k0, y0, g, i), fb, cp);
        cq = MFMA16(frag_col(lds + L_WH, k0, y0, g, i), fb, cq); cq = MFMA16(frag_col(lds + L_VV, k0, y0, g, i), fk, cq);
    }
    const float gm = ((const LAS float*)(lds + L_TOT))[x0 + i];
#pragma unroll
    for (int q = 0; q < 4; ++q) if (y0 + 4 * g + q == x0 + i) cp[q] += gm;
}

struct ScanBufs { bf16_t* pm; bf16_t* qm; bf16_t* rh; bf16_t* yh; bf16_t* st; float* bonus; };
constexpr int NCHUNK = T / CL;
__device__ __forceinline__ void g_st4(bf16_t* p, const f32x4& v) { u32x2 w; w.x = cvtpk_c(v[0], v[1]); w.y = cvtpk_c(v[2], v[3]); *(u32x2*)p = w; }
__device__ __forceinline__ void scan_sa(LAS unsigned char* lds, const ScanArgs& a, const ScanBufs& sb, int G, int bid) {
    const int tid = threadIdx.x, lane = tid & 63, w = __builtin_amdgcn_readfirstlane(tid >> 6), g = lane >> 4, i = lane & 15;
    const int total = BATCH * NH * NCHUNK, per = (total + G - 1) / G;
    const int gc_end = ((bid + 1) * per < total) ? (bid + 1) * per : total;
    ChunkRaw raw;
    if (bid * per < gc_end) { const int gc = bid * per, bh = gc >> 7, c = gc & (NCHUNK - 1); chunk_load(raw, a, (size_t)(bh >> 4) * T + (size_t)c * CL, bh & 15); }
    for (int gc = bid * per; gc < gc_end; ++gc) {
        const int bh = gc >> 7, h = bh & 15;
        __syncthreads();
        ChunkRaw cur = raw;
        if (gc + 1 < gc_end) { const int g2 = gc + 1, bh2 = g2 >> 7, c2 = g2 & (NCHUNK - 1); chunk_load(raw, a, (size_t)(bh2 >> 4) * T + (size_t)c2 * CL, bh2 & 15); }
        chunk_build(lds, a, cur, h, sb.bonus + (size_t)gc * CL, nullptr);
        const size_t ob = (size_t)gc * 4096;
        for (int rep_ = 0; rep_ < (SA_PROBE == 6 ? 2 : 1); ++rep_)
#pragma unroll
        for (int tt = 0; tt < 2; ++tt) {
            const int t = w + 8 * tt, x0 = 16 * (t >> 2), y0 = 16 * (t & 3), x = x0 + i, y = y0 + 4 * g;
            f32x4 cr = {0.f, 0.f, 0.f, 0.f}, cy = cr;
#pragma unroll
            for (int k0 = 0; k0 < 64; k0 += 32) {
                const bf16x8 fa = frag_row(lds + L_ARB, x0, k0, g, i), fk = frag_row(lds + L_ARK, x0, k0, g, i);
                cr = MFMA16(frag_col(lds + L_NH, k0, y0, g, i), fa, cr);
                cy = MFMA16(frag_col(lds + L_WH, k0, y0, g, i), fa, cy); cy = MFMA16(frag_col(lds + L_VV, k0, y0, g, i), fk, cy);
            }
            const u32x2 rt = *(const LAS u32x2*)(lds + L_RT + x * MROW + y * 2);
            cr[0] += bflo(rt.x); cr[1] += bfhi(rt.x); cr[2] += bflo(rt.y); cr[3] += bfhi(rt.y);
            g_st4(sb.rh + ob + x * 64 + y, cr); g_st4(sb.yh + ob + x * 64 + y, cy);
            f32x4 cp, cq; chunk_pq_tile(lds, x0, y0, g, i, cp, cq);
            g_st4(sb.pm + ob + x * 64 + y, cp); g_st4(sb.qm + ob + x * 64 + y, cq);
        }
    }
}
__device__ __forceinline__ void scan_sb(LAS unsigned char* lds, const ScanBufs& sb, int G, int bid) {
    const int tid = threadIdx.x, lane = tid & 63, w = __builtin_amdgcn_readfirstlane(tid >> 6), g = lane >> 4, i = lane & 15;
    const int srow = tid >> 3, sch = tid & 7, soff = srow * MROW + sch * 16;
    for (int bh = bid; bh < BATCH * NH; bh += G) {
        __syncthreads();
        *(LAS u32x4*)(lds + soff) = (u32x4){0u, 0u, 0u, 0u};
        const size_t gb = (size_t)bh * NCHUNK * 4096;
        u32x4 pmr = *(const u32x4*)(sb.pm + gb + srow * 64 + sch * 8);
        u32x2 qn[2];
#pragma unroll
        for (int tt = 0; tt < 2; ++tt) { const int t = w + 8 * tt; qn[tt] = *(const u32x2*)(sb.qm + gb + (16 * (t >> 2) + i) * 64 + 16 * (t & 3) + 4 * g); }
        for (int c = 0; c < NCHUNK; ++c) {
            const size_t ob = gb + (size_t)c * 4096;
            *(LAS u32x4*)(lds + (2 + (c & 1)) * MSZ + soff) = pmr;
            if (c + 1 < NCHUNK) pmr = *(const u32x4*)(sb.pm + ob + 4096 + srow * 64 + sch * 8);
            u32x2 qv[2] = {qn[0], qn[1]};
            if (c + 1 < NCHUNK) {
#pragma unroll
                for (int tt = 0; tt < 2; ++tt) { const int t = w + 8 * tt; qn[tt] = *(const u32x2*)(sb.qm + ob + 4096 + (16 * (t >> 2) + i) * 64 + 16 * (t & 3) + 4 * g); }
            }
            __syncthreads();
            const LAS unsigned char* scur = lds + (c & 1) * MSZ; LAS unsigned char* snxt = lds + ((c + 1) & 1) * MSZ; const LAS unsigned char* pimg = lds + (2 + (c & 1)) * MSZ;
            if (c > 0) *(u32x4*)(sb.pm + ob - 4096 + srow * 64 + sch * 8) = *(const LAS u32x4*)(scur + soff);
#pragma unroll
            for (int tt = 0; tt < 2; ++tt) {
                const int t = w + 8 * tt, x0 = 16 * (t >> 2), y0 = 16 * (t & 3);
                f32x4 acc = {bflo(qv[tt].x), bfhi(qv[tt].x), bflo(qv[tt].y), bfhi(qv[tt].y)};
#pragma unroll
                for (int k0 = 0; k0 < 64; k0 += 32) acc = MFMA16(frag_col(scur, k0, y0, g, i), frag_row(pimg, x0, k0, g, i), acc);
                st_bf16x4(snxt, x0 + i, y0 + 4 * g, acc);
            }
        }
    }
}
__device__ __forceinline__ void scan_sc(LAS unsigned char* lds, const ScanArgs& a, const ScanBufs& sb, int G, int bid) {
    const int tid = threadIdx.x, lane = tid & 63, w = __builtin_amdgcn_readfirstlane(tid >> 6), g = lane >> 4, i = lane & 15, half = w >> 2, wq = w & 3;
    const int ht = tid & 255, srow = ht >> 2, sch = ht & 3;
    LAS unsigned char* rimg = lds + half * 2 * MSZ; LAS unsigned char* simg = rimg + MSZ;
    const int total = BATCH * NH * NCHUNK / 2, per = (total + G - 1) / G;
    for (int pc = bid * per; pc < (bid + 1) * per && pc < total; ++pc) {
        const int gc = 2 * pc + half, bh = gc >> 7, c = gc & (NCHUNK - 1), b = bh >> 4, h = bh & 15;
        const size_t ob = (size_t)gc * 4096, m0 = (size_t)b * T + (size_t)c * CL;
        __syncthreads();
#pragma unroll
        for (int q = 0; q < 2; ++q) { const int ch = sch + 4 * q;
            *(LAS u32x4*)(rimg + srow * MROW + ch * 16) = *(const u32x4*)(sb.rh + ob + srow * 64 + ch * 8);
            *(LAS u32x4*)(simg + srow * MROW + ch * 16) = c > 0 ? *(const u32x4*)(sb.pm + ob - 4096 + srow * 64 + ch * 8) : (u32x4){0u, 0u, 0u, 0u}; }
        __syncthreads();
        const int x0 = 16 * wq, s = x0 + i; const size_t m = m0 + s;
        f32x4 y[4]; float sum = 0.f;
#pragma unroll
        for (int vt = 0; vt < 4; ++vt) {
            const u32x2 yv = *(const u32x2*)(sb.yh + ob + s * 64 + 16 * vt + 4 * g);
            f32x4 acc = {bflo(yv.x), bfhi(yv.x), bflo(yv.y), bfhi(yv.y)};
#pragma unroll
            for (int k0 = 0; k0 < 64; k0 += 32) acc = MFMA16(frag_col(simg, k0, 16 * vt, g, i), frag_row(rimg, x0, k0, g, i), acc);
            y[vt] = acc; sum += (acc[0] + acc[1]) + (acc[2] + acc[3]);
        }
        const float mean = xsum4(sum) * (1.0f / 64.0f); float sq = 0.f;
#pragma unroll
        for (int vt = 0; vt < 4; ++vt) { y[vt] = y[vt] - mean; sq += (y[vt][0] * y[vt][0] + y[vt][1] * y[vt][1]) + (y[vt][2] * y[vt][2] + y[vt][3] * y[vt][3]); }
        const float rstd = __builtin_amdgcn_rsqf(xsum4(sq) * (1.0f / 64.0f) + LNX_EPS);
        const float bo = sb.bonus[(size_t)gc * CL + s];
#pragma unroll
        for (int vt = 0; vt < 4; ++vt) {
            const int v0 = h * 64 + 16 * vt + 4 * g;
            const f32x4 lg = *(const f32x4*)(a.lnx_g + v0), lb = *(const f32x4*)(a.lnx_b + v0);
            const u32x2 vc = *(const u32x2*)(a.zr + m * RC + 2048 + v0), gg = *(const u32x2*)(a.ymix + m * D + v0);
            const u32x2 vp = ((m & (T - 1)) == 0) ? (u32x2){0u, 0u} : *(const u32x2*)(a.zr + (m - 1) * RC + 2048 + v0);
            const f32x4 mv = *(const f32x4*)(a.mu + 2048 + v0);
            const float vs0 = bflo(vc.x) + (bflo(vp.x) - bflo(vc.x)) * mv[0], vs1 = bfhi(vc.x) + (bfhi(vp.x) - bfhi(vc.x)) * mv[1], vs2 = bflo(vc.y) + (bflo(vp.y) - bflo(vc.y)) * mv[2], vs3 = bfhi(vc.y) + (bfhi(vp.y) - bfhi(vc.y)) * mv[3];
            f32x4 o;
            o[0] = (y[vt][0] * rstd * lg[0] + lb[0] + bo * vs0) * bflo(gg.x); o[1] = (y[vt][1] * rstd * lg[1] + lb[1] + bo * vs1) * bfhi(gg.x);
            o[2] = (y[vt][2] * rstd * lg[2] + lb[2] + bo * vs2) * bflo(gg.y); o[3] = (y[vt][3] * rstd * lg[3] + lb[3] + bo * vs3) * bfhi(gg.y);
            g_st4(a.ymix + m * D + v0, o);
        }
    }
}

#define TK_INS(t, xin) do { float x_ = (xin); _Pragma("unroll") for (int j_ = 0; j_ < 16; ++j_) { const float hi_ = fmaxf(t[j_], x_); x_ = fminf(t[j_], x_); t[j_] = hi_; } } while (0)
#define CE_DESC(a, b) do { const float hi_ = fmaxf(a, b), lo_ = fminf(a, b); a = hi_; b = lo_; } while (0)
__device__ __forceinline__ void sort16_desc(float (&v)[16]) {
#pragma unroll
    for (int k = 2; k <= 16; k <<= 1)
#pragma unroll
        for (int j = k >> 1; j > 0; j >>= 1)
#pragma unroll
            for (int i = 0; i < 16; ++i) { const int l = i ^ j; if (l > i) { if ((i & k) == 0) CE_DESC(v[i], v[l]); else CE_DESC(v[l], v[i]); } }
}
__device__ __forceinline__ void merge16_desc(float (&t)[16], const float (&v)[16]) {
#pragma unroll
    for (int i = 0; i < 16; ++i) t[i] = fmaxf(t[i], v[15 - i]);
#pragma unroll
    for (int j = 8; j > 0; j >>= 1)
#pragma unroll
        for (int i = 0; i < 16; ++i) { const int l = i ^ j; if (l > i) CE_DESC(t[i], t[l]); }
}
__device__ __forceinline__ void topk_phase(LAS unsigned char* lds, const float* s, int* eidx, float* gates, int G, int bid) {
    const int tid = threadIdx.x;
    LAS unsigned short* el = (LAS unsigned short*)lds;
    LAS float* buf = (LAS float*)(lds + 50 * 512 * 2);
    for (int blk = bid; blk < M * PH / 512; blk += G) {
        const float* sb = s + (size_t)blk * 512 * 256;
        float ta[16], tb[16], tc[16];
#pragma unroll
        for (int j = 0; j < 16; ++j) { ta[j] = -INFINITY; tb[j] = -INFINITY; tc[j] = -INFINITY; }
        f32x4 pre[8];
#pragma unroll
        for (int q = 0; q < 8; ++q) { const int idx = tid + 512 * q, f4 = idx & 7; pre[q] = *(const f32x4*)(sb + (size_t)(idx >> 3) * 256 + (f4 >> 2) * 128 + (f4 & 3) * 4); }
#pragma unroll
        for (int cc = 0; cc < 8; ++cc) {
            __syncthreads();
#pragma unroll
            for (int q = 0; q < 8; ++q) { const int idx = tid + 512 * q; LAS float* d = buf + (idx >> 3) * 33 + (idx & 7) * 4; d[0] = pre[q][0]; d[1] = pre[q][1]; d[2] = pre[q][2]; d[3] = pre[q][3]; }
            if (cc + 1 < 8) {
#pragma unroll
                for (int q = 0; q < 8; ++q) { const int idx = tid + 512 * q, f4 = idx & 7; pre[q] = *(const f32x4*)(sb + (size_t)(idx >> 3) * 256 + (f4 >> 2) * 128 + (cc + 1) * 16 + (f4 & 3) * 4); }
            }
            __syncthreads();
            float va[16], vb[16];
#pragma unroll
            for (int j = 0; j < 16; ++j) {
                const float fa = buf[tid * 33 + j], fb = buf[tid * 33 + 16 + j];
                va[j] = __uint_as_float((__float_as_uint(fa) & ~127u) | (unsigned)(cc * 16 + j)); vb[j] = __uint_as_float((__float_as_uint(fb) & ~127u) | (unsigned)(cc * 16 + j));
            }
            sort16_desc(va); sort16_desc(vb);
            if (cc == 0) {
#pragma unroll
                for (int j = 0; j < 16; ++j) { ta[j] = va[j]; tb[j] = vb[j]; }
            } else { merge16_desc(ta, va); merge16_desc(tb, vb); }
        }
        int kc = 0;
        float cv[4][16];
#pragma unroll
        for (int gq = 0; gq < 4; ++gq)
#pragma unroll
            for (int j = 0; j < 16; ++j) cv[gq][j] = -INFINITY;
#pragma unroll
        for (int i = 0; i < 16; ++i)
#pragma unroll
            for (int j = 0; j < 16; ++j)
                if ((i + 1) * (j + 1) <= 16) {
                    const unsigned ba = __float_as_uint(ta[i]), bb = __float_as_uint(tb[j]);
                    const float sum = __uint_as_float(ba & ~127u) + __uint_as_float(bb & ~127u);
                    const float xc = __uint_as_float((__float_as_uint(sum) & ~63u) | (unsigned)kc);
                    el[kc * 512 + tid] = (unsigned short)(((ba & 127u) << 7) | (bb & 127u));
                    cv[kc >> 4][kc & 15] = xc;
                    ++kc;
                }
#pragma unroll
        for (int gq = 0; gq < 4; ++gq) sort16_desc(cv[gq]);
#pragma unroll
        for (int j = 0; j < 16; ++j) tc[j] = cv[0][j];
        merge16_desc(tc, cv[1]); merge16_desc(tc, cv[2]); merge16_desc(tc, cv[3]);
        float ex[16], den = 0.f;
#pragma unroll
        for (int j = 0; j < 16; ++j) { ex[j] = __expf(tc[j] - tc[0]); den += ex[j]; }
        const float inv = 1.0f / den;
        int ev[16];
#pragma unroll
        for (int j = 0; j < 16; ++j) ev[j] = (int)el[(__float_as_uint(tc[j]) & 63u) * 512 + tid];
        const size_t idx = (size_t)blk * 512 + tid;
        int* eo = eidx + idx * 16; float* go = gates + idx * 16;
#pragma unroll
        for (int j = 0; j < 16; j += 4) { *(int4*)(eo + j) = make_int4(ev[j], ev[j + 1], ev[j + 2], ev[j + 3]);
            *(f32x4*)(go + j) = (f32x4){ex[j] * inv, ex[j + 1] * inv, ex[j + 2] * inv, ex[j + 3] * inv}; }
    }
}

__device__ __forceinline__ float gelu_tanh(float x) { const float u = 0.7978845608028654f * (x + 0.044715f * x * x * x); const float t = 1.0f - 2.0f / (__expf(2.0f * u) + 1.0f); return 0.5f * x * (1.0f + t); }
__device__ __forceinline__ void quant_u4(const float* src, unsigned char* dst, float* scale, int G, int bid) {
    const int lane = threadIdx.x & 63, wave = __builtin_amdgcn_readfirstlane(threadIdx.x >> 6);
    for (int e = bid * NWAVES + wave; e < NEXP; e += G * NWAVES) {
        const f32x4* r = (const f32x4*)(src + (size_t)e * D + 32 * lane);
        f32x4 v[8]; float mx = 0.f, sq = 0.f;
#pragma unroll
        for (int q = 0; q < 8; ++q) { const f32x4 t = r[q]; v[q] = t; mx = fmaxf(mx, fmaxf(fmaxf(fabsf(t[0]), fabsf(t[1])), fmaxf(fabsf(t[2]), fabsf(t[3])))); sq += (t[0] * t[0] + t[1] * t[1]) + (t[2] * t[2] + t[3] * t[3]); }
#pragma unroll
        for (int o = 1; o < 64; o <<= 1) { mx = fmaxf(mx, __shfl_xor(mx, o)); sq += __shfl_xor(sq, o); }
        const float sc = fmaxf(fmaxf(0.335f * sqrtf(sq * (1.0f / D)), mx * (1.0f / 20.0f)), 1e-30f), inv = 1.0f / sc;
        if (lane == 0) scale[e] = sc;
        u32x4 o;
#pragma unroll
        for (int p = 0; p < 4; ++p) { unsigned w = 0u;
#pragma unroll
            for (int k = 0; k < 4; ++k) {
                const int lo = min(max(__float2int_rn(v[2 * p][k] * inv), -7), 7) + 8, hi = min(max(__float2int_rn(v[2 * p + 1][k] * inv), -7), 7) & 15;
                w |= (unsigned)(lo | (hi << 4)) << (8 * k); }
            o[p] = w; }
        *(u32x4*)(dst + (size_t)e * 1024 + 16 * lane) = o;
    }
}
__device__ __forceinline__ void quant_v8(const float* src, unsigned char* dst, float* scale, int G, int bid) {
    const int lane = threadIdx.x & 63, wave = __builtin_amdgcn_readfirstlane(threadIdx.x >> 6);
    for (int e = bid * NWAVES + wave; e < NEXP; e += G * NWAVES) {
        const f32x4* r = (const f32x4*)(src + (size_t)e * D + 32 * lane);
        f32x4 v[8]; float mx = 0.f;
#pragma unroll
        for (int q = 0; q < 8; ++q) { const f32x4 t = r[q]; v[q] = t; mx = fmaxf(mx, fmaxf(fmaxf(fabsf(t[0]), fabsf(t[1])), fmaxf(fabsf(t[2]), fabsf(t[3])))); }
#pragma unroll
        for (int o = 1; o < 64; o <<= 1) mx = fmaxf(mx, __shfl_xor(mx, o));
        const float sc = fmaxf(mx, 1e-30f) * (1.0f / 127.0f), inv = 1.0f / sc;
        if (lane == 0) scale[e] = sc;
#pragma unroll
        for (int hq = 0; hq < 2; ++hq) { u32x4 o;
#pragma unroll
            for (int p = 0; p < 4; ++p) { const f32x4 t = v[4 * hq + p];
                o[p] = ((unsigned)__float2int_rn(t[0] * inv) & 0xffu) | (((unsigned)__float2int_rn(t[1] * inv) & 0xffu) << 8) | (((unsigned)__float2int_rn(t[2] * inv) & 0xffu) << 16) | ((unsigned)__float2int_rn(t[3] * inv) << 24); }
            *(u32x4*)(dst + (size_t)e * D + 32 * lane + 16 * hq) = o; }
    }
}

struct GatherArgs { const bf16_t* h1; bf16_t* h2; const float* ss2; const float* g2; const unsigned char* uq; const unsigned char* vq; const float* su; const float* sv; const int* eidx; const float* gates; bf16_t* hb; float* rs3; };
__device__ __forceinline__ float wave_max_all(float v) {
#pragma unroll
    for (int o = 1; o < 64; o <<= 1) v = fmaxf(v, __shfl_xor(v, o));
    return v;
}
__device__ __forceinline__ int wave_isum_to63(int v) {
    v += __builtin_amdgcn_update_dpp(0, v, 0x111, 0xF, 0xF, true);
    v += __builtin_amdgcn_update_dpp(0, v, 0x112, 0xF, 0xF, true);
    v += __builtin_amdgcn_update_dpp(0, v, 0x114, 0xF, 0xF, true);
    v += __builtin_amdgcn_update_dpp(0, v, 0x118, 0xF, 0xF, true);
    v += __builtin_amdgcn_update_dpp(0, v, 0x142, 0xA, 0xF, false);
    v += __builtin_amdgcn_update_dpp(0, v, 0x143, 0xC, 0xF, false);
    return v;
}
constexpr int GNS = 4, GPD = 3;
template <bool LOCAL> __device__ __forceinline__ void gather_phase(LAS unsigned char* lds, const GatherArgs& a, int G, int bid) {
    const int tid = threadIdx.x, lane = tid & 63, wave = __builtin_amdgcn_readfirstlane(tid >> 6);
    for (int m = LOCAL ? 64 * bid + wave : bid * NWAVES + wave; m < (LOCAL ? 64 * bid + 64 : M); m += (LOCAL ? NWAVES : G * NWAVES)) {
        const float rs = 1.0f / sqrtf(a.ss2[m] * (1.0f / D) + NORM_EPS);
        int xq[8]; int xsum = 0; float sx; u32x4 h1p[4];
        {
            float x[32]; float mx = 0.f;
#pragma unroll
            for (int q = 0; q < 4; ++q) { h1p[q] = *(const u32x4*)(a.h1 + (size_t)m * D + 32 * lane + 8 * q);
                const f32x4 ga = *(const f32x4*)(a.g2 + 32 * lane + 8 * q), gb = *(const f32x4*)(a.g2 + 32 * lane + 8 * q + 4);
                const float hv[8] = {bflo(h1p[q].x), bfhi(h1p[q].x), bflo(h1p[q].y), bfhi(h1p[q].y), bflo(h1p[q].z), bfhi(h1p[q].z), bflo(h1p[q].w), bfhi(h1p[q].w)};
                const float gv[8] = {ga[0], ga[1], ga[2], ga[3], gb[0], gb[1], gb[2], gb[3]};
#pragma unroll
                for (int e = 0; e < 8; ++e) { const float xv = hv[e] * rs * gv[e]; x[8 * q + e] = xv; mx = fmaxf(mx, fabsf(xv)); } }
            mx = wave_max_all(mx);
            sx = fmaxf(mx, 1e-30f) * (1.0f / 127.0f); const float inv = 1.0f / sx;
#pragma unroll
            for (int k = 0; k < 8; ++k) { const int q0 = __float2int_rn(x[4 * k] * inv), q1 = __float2int_rn(x[4 * k + 1] * inv), q2 = __float2int_rn(x[4 * k + 2] * inv), q3 = __float2int_rn(x[4 * k + 3] * inv);
                if ((k & 1) == 0) xsum += (q0 + q1) + (q2 + q3); xq[k] = (int)(((unsigned)q0 & 0xffu) | (((unsigned)q1 & 0xffu) << 8) | (((unsigned)q2 & 0xffu) << 16) | ((unsigned)q3 << 24)); }
        }
        const int x8 = 128 * __builtin_amdgcn_readlane(wave_isum_to63(xsum), 63);
        int e_lo = a.eidx[(size_t)m * 128 + lane], e_hi = a.eidx[(size_t)m * 128 + 64 + lane];
        float gt_lo = a.gates[(size_t)m * 128 + lane], gt_hi = a.gates[(size_t)m * 128 + 64 + lane];
        {
            LAS unsigned* sl = (LAS unsigned*)(lds + wave * 1024);
            const int b0 = e_lo >> 10, b1 = e_hi >> 10;
            int r0 = 0, r1 = 0, base = 0;
#pragma unroll
            for (int b = 0; b < 16; ++b) {
                const unsigned long long m0 = __builtin_amdgcn_ballot_w64(b0 == b), m1 = __builtin_amdgcn_ballot_w64(b1 == b);
                const int c0 = __builtin_popcountll(m0), c1 = __builtin_popcountll(m1);
                const int p0 = __builtin_amdgcn_mbcnt_hi((unsigned)(m0 >> 32), __builtin_amdgcn_mbcnt_lo((unsigned)m0, 0u));
                const int p1 = __builtin_amdgcn_mbcnt_hi((unsigned)(m1 >> 32), __builtin_amdgcn_mbcnt_lo((unsigned)m1, 0u));
                if (b0 == b) r0 = base + p0;
                if (b1 == b) r1 = base + c0 + p1;
                base += c0 + c1;
            }
            sl[r0] = (unsigned)e_lo; sl[r1] = (unsigned)e_hi; sl[128 + r0] = __float_as_uint(gt_lo); sl[128 + r1] = __float_as_uint(gt_hi);
            LDS_WAIT();
            e_lo = (int)sl[lane]; e_hi = (int)sl[64 + lane]; gt_lo = __uint_as_float(sl[128 + lane]); gt_hi = __uint_as_float(sl[192 + lane]);
            LDS_WAIT();
        }
        const float su_lo = a.su[e_lo], su_hi = a.su[e_hi], sv_lo = a.sv[e_lo], sv_hi = a.sv[e_hi];
        int d_lo = 0, d_hi = 0;
        u32x4 ring[GNS][4];
#define G_LOAD(g, s) do { const int gg_ = ((g) < 64) ? (g) : 63; const int ev_ = ((gg_ & 31) >= 16) ? e_hi : e_lo; const unsigned char* tb_ = (gg_ < 32) ? a.uq : a.vq; _Pragma("unroll") for (int c_ = 0; c_ < 4; ++c_) { const int e_ = __builtin_amdgcn_readlane(ev_, (gg_ & 15) * 4 + c_); ring[s][c_] = *(const u32x4*)(tb_ + (size_t)e_ * 1024 + 16 * lane); } } while (0)
        {
#pragma unroll
            for (int s = 0; s < GPD; ++s) G_LOAD(s, s);
            int dreg = 0;
#pragma unroll 1
            for (int g0 = 0; g0 < 32; g0 += GNS) {
                if (LOCAL && (g0 & 7) == 0) __builtin_amdgcn_s_barrier();
#pragma unroll
                for (int s = 0; s < GNS; ++s) {
                    const int g = g0 + s;
                    G_LOAD(g + GPD, (s + GPD) % GNS);
                    if (g == 16) { d_lo = dreg; dreg = 0; }
#pragma unroll
                    for (int c = 0; c < 4; ++c) { int p = 0, ph = 0;
#pragma unroll
                        for (int k = 0; k < 4; ++k) { const unsigned wv = ring[s][c][k]; p = __builtin_amdgcn_sdot4((int)(wv & 0x0F0F0F0Fu), xq[2 * k], p, false); ph = __builtin_amdgcn_sdot4((int)(wv & 0xF0F0F0F0u), xq[2 * k + 1], ph, false); }
                        const int tot = __builtin_amdgcn_readlane(wave_isum_to63(16 * p + ph), 63);
                        dreg = (lane == (g & 15) * 4 + c) ? tot : dreg; }
                }
            }
            d_hi = dreg;
        }
        const float c_lo = gt_lo * gelu_tanh((float)(d_lo - x8) * (sx * 0.0625f * su_lo)) * sv_lo;
        const float c_hi = gt_hi * gelu_tanh((float)(d_hi - x8) * (sx * 0.0625f * su_hi)) * sv_hi;
        const float cmx = wave_max_all(fmaxf(fabsf(c_lo), fabsf(c_hi)));
        const float cs = fmaxf(cmx, 1e-30f) * (1.0f / 127.0f), cinv = 1.0f / cs;
        int pk_lo = (int)(((unsigned)__float2int_rn(c_lo * cinv) & 0xffu) << (8 * (lane & 3))), pk_hi = (int)(((unsigned)__float2int_rn(c_hi * cinv) & 0xffu) << (8 * (lane & 3)));
        pk_lo |= __builtin_amdgcn_update_dpp(0, pk_lo, 0xB1, 0xF, 0xF, true); pk_lo |= __builtin_amdgcn_update_dpp(0, pk_lo, 0x4E, 0xF, 0xF, true);
        pk_hi |= __builtin_amdgcn_update_dpp(0, pk_hi, 0xB1, 0xF, 0xF, true); pk_hi |= __builtin_amdgcn_update_dpp(0, pk_hi, 0x4E, 0xF, 0xF, true);
        int acc[32];
#pragma unroll
        for (int i = 0; i < 32; ++i) acc[i] = 0;
        const int cq8 = 8 * __builtin_amdgcn_readlane(wave_isum_to63(__float2int_rn(c_lo * cinv) + __float2int_rn(c_hi * cinv)), 63);
        {
#pragma unroll 1
            for (int g0 = 32; g0 < 64; g0 += GNS) {
                if (LOCAL && (g0 & 7) == 0) __builtin_amdgcn_s_barrier();
#pragma unroll
                for (int s = 0; s < GNS; ++s) {
                    const int g = g0 + s;
                    G_LOAD(g + GPD, (s + GPD) % GNS);
                    const int cpk = __builtin_amdgcn_readlane((g >= 48) ? pk_hi : pk_lo, (g & 15) * 4);
#pragma unroll
                    for (int p = 0; p < 4; ++p) {
                        const unsigned A = ring[s][0][p], B = ring[s][1][p], C = ring[s][2][p], Dd = ring[s][3][p];
                        const unsigned ab_lo = __builtin_amdgcn_perm(B, A, 0x05010400u), ab_hi = __builtin_amdgcn_perm(B, A, 0x07030602u), cd_lo = __builtin_amdgcn_perm(Dd, C, 0x05010400u), cd_hi = __builtin_amdgcn_perm(Dd, C, 0x07030602u);
                        const unsigned t0 = __builtin_amdgcn_perm(cd_lo, ab_lo, 0x05040100u), t1 = __builtin_amdgcn_perm(cd_lo, ab_lo, 0x07060302u), t2 = __builtin_amdgcn_perm(cd_hi, ab_hi, 0x05040100u), t3 = __builtin_amdgcn_perm(cd_hi, ab_hi, 0x07060302u);
                        acc[8 * p + 0] = __builtin_amdgcn_sdot4((int)(t0 & 0x0F0F0F0Fu), cpk, acc[8 * p + 0], false); acc[8 * p + 4] = __builtin_amdgcn_sdot4((int)(t0 & 0xF0F0F0F0u), cpk, acc[8 * p + 4], false);
                        acc[8 * p + 1] = __builtin_amdgcn_sdot4((int)(t1 & 0x0F0F0F0Fu), cpk, acc[8 * p + 1], false); acc[8 * p + 5] = __builtin_amdgcn_sdot4((int)(t1 & 0xF0F0F0F0u), cpk, acc[8 * p + 5], false);
                        acc[8 * p + 2] = __builtin_amdgcn_sdot4((int)(t2 & 0x0F0F0F0Fu), cpk, acc[8 * p + 2], false); acc[8 * p + 6] = __builtin_amdgcn_sdot4((int)(t2 & 0xF0F0F0F0u), cpk, acc[8 * p + 6], false);
                        acc[8 * p + 3] = __builtin_amdgcn_sdot4((int)(t3 & 0x0F0F0F0Fu), cpk, acc[8 * p + 3], false); acc[8 * p + 7] = __builtin_amdgcn_sdot4((int)(t3 & 0xF0F0F0F0u), cpk, acc[8 * p + 7], false);
                    }
                }
            }
        }
#undef G_LOAD
#pragma unroll
        for (int p = 0; p < 4; ++p)
#pragma unroll
            for (int k = 0; k < 4; ++k) acc[8 * p + k] = 16 * (acc[8 * p + k] - cq8);

        float hn[32]; float ssq = 0.f, hmx = 0.f;
#pragma unroll
        for (int q = 0; q < 4; ++q) {
            const float hv[8] = {bflo(h1p[q].x), bfhi(h1p[q].x), bflo(h1p[q].y), bfhi(h1p[q].y), bflo(h1p[q].z), bfhi(h1p[q].z), bflo(h1p[q].w), bfhi(h1p[q].w)};
#pragma unroll
            for (int e = 0; e < 8; ++e) { const float nv = hv[e] + (cs * 0.0625f) * (float)acc[8 * q + e]; ssq += nv * nv; hmx = fmaxf(hmx, fabsf(nv)); hn[8 * q + e] = nv; }
            u32x4 w; w.x = pk2(hn[8 * q], hn[8 * q + 1]); w.y = pk2(hn[8 * q + 2], hn[8 * q + 3]); w.z = pk2(hn[8 * q + 4], hn[8 * q + 5]); w.w = pk2(hn[8 * q + 6], hn[8 * q + 7]);
            *(u32x4*)(a.h2 + (size_t)m * D + 32 * lane + 8 * q) = w;
        }
        ssq = wave_sum_dpp(ssq); hmx = wave_max_all(hmx);
        const float hstep = fmaxf(hmx, 1e-30f) * (1.0f / 127.0f), hinv = 1.0f / hstep;
        if (lane == 0) a.rs3[m] = hstep / sqrtf(ssq * (1.0f / D) + NORM_EPS);
#pragma unroll
        for (int hq = 0; hq < 2; ++hq) { u32x4 qw;
#pragma unroll
            for (int p = 0; p < 4; ++p) { const int b = 16 * hq + 4 * p; qw[p] = ((unsigned)__float2int_rn(hn[b] * hinv) & 0xffu) | (((unsigned)__float2int_rn(hn[b + 1] * hinv) & 0xffu) << 8) | (((unsigned)__float2int_rn(hn[b + 2] * hinv) & 0xffu) << 16) | ((unsigned)__float2int_rn(hn[b + 3] * hinv) << 24); }
            *(u32x4*)((unsigned char*)a.hb + (size_t)m * D + 32 * lane + 16 * hq) = qw; }
    }
}
__device__ __forceinline__ void gather_phase2(LAS unsigned char* lds, const GatherArgs& a, int bid) {
    const int tid = threadIdx.x, lane = tid & 63, wave = __builtin_amdgcn_readfirstlane(tid >> 6);
    const int lane16 = 16 * lane;
    for (int mb = 64 * bid + wave; mb < 64 * bid + 64; mb += 2 * NWAVES) {
        int xq[2][8], x8[2], e_lo[2], e_hi[2]; float sx[2], gt_lo[2], gt_hi[2], su_lo[2], su_hi[2], sv_lo[2], sv_hi[2]; u32x4 h1p[2][4];
#pragma unroll
        for (int t = 0; t < 2; ++t) {
            const int m = mb + t * NWAVES;
            const float rs = 1.0f / sqrtf(a.ss2[m] * (1.0f / D) + NORM_EPS);
            int xsum = 0;
            {
                float x[32]; float mx = 0.f;
#pragma unroll
                for (int q = 0; q < 4; ++q) { h1p[t][q] = *(const u32x4*)(a.h1 + (size_t)m * D + 32 * lane + 8 * q);
                    const f32x4 ga = *(const f32x4*)(a.g2 + 32 * lane + 8 * q), gb = *(const f32x4*)(a.g2 + 32 * lane + 8 * q + 4);
                    const float hv[8] = {bflo(h1p[t][q].x), bfhi(h1p[t][q].x), bflo(h1p[t][q].y), bfhi(h1p[t][q].y), bflo(h1p[t][q].z), bfhi(h1p[t][q].z), bflo(h1p[t][q].w), bfhi(h1p[t][q].w)};
                    const float gv[8] = {ga[0], ga[1], ga[2], ga[3], gb[0], gb[1], gb[2], gb[3]};
#pragma unroll
                    for (int e = 0; e < 8; ++e) { const float xv = hv[e] * rs * gv[e]; x[8 * q + e] = xv; mx = fmaxf(mx, fabsf(xv)); } }
                mx = wave_max_all(mx);
                sx[t] = fmaxf(mx, 1e-30f) * (1.0f / 127.0f); const float inv = 1.0f / sx[t];
#pragma unroll
                for (int k = 0; k < 8; ++k) { const int q0 = __float2int_rn(x[4 * k] * inv), q1 = __float2int_rn(x[4 * k + 1] * inv), q2 = __float2int_rn(x[4 * k + 2] * inv), q3 = __float2int_rn(x[4 * k + 3] * inv);
                    if ((k & 1) == 0) xsum += (q0 + q1) + (q2 + q3); xq[t][k] = (int)(((unsigned)q0 & 0xffu) | (((unsigned)q1 & 0xffu) << 8) | (((unsigned)q2 & 0xffu) << 16) | ((unsigned)q3 << 24)); }
            }
            x8[t] = 128 * __builtin_amdgcn_readlane(wave_isum_to63(xsum), 63);
            int el = a.eidx[(size_t)m * 128 + lane], eh = a.eidx[(size_t)m * 128 + 64 + lane];
            float gl = a.gates[(size_t)m * 128 + lane], gh = a.gates[(size_t)m * 128 + 64 + lane];
            {
                LAS unsigned* sl = (LAS unsigned*)(lds + wave * 1024);
                const int b0 = el >> 10, b1 = eh >> 10;
                int r0 = 0, r1 = 0, base = 0;
#pragma unroll
                for (int b = 0; b < 16; ++b) {
                    const unsigned long long m0 = __builtin_amdgcn_ballot_w64(b0 == b), m1 = __builtin_amdgcn_ballot_w64(b1 == b);
                    const int c0 = __builtin_popcountll(m0), c1 = __builtin_popcountll(m1);
                    const int p0 = __builtin_amdgcn_mbcnt_hi((unsigned)(m0 >> 32), __builtin_amdgcn_mbcnt_lo((unsigned)m0, 0u));
                    const int p1 = __builtin_amdgcn_mbcnt_hi((unsigned)(m1 >> 32), __builtin_amdgcn_mbcnt_lo((unsigned)m1, 0u));
                    if (b0 == b) r0 = base + p0;
                    if (b1 == b) r1 = base + c0 + p1;
                    base += c0 + c1;
                }
                sl[r0] = (unsigned)el; sl[r1] = (unsigned)eh; sl[128 + r0] = __float_as_uint(gl); sl[128 + r1] = __float_as_uint(gh);
                LDS_WAIT();
                el = (int)sl[lane]; eh = (int)sl[64 + lane]; gl = __uint_as_float(sl[128 + lane]); gh = __uint_as_float(sl[192 + lane]);
                LDS_WAIT();
            }
            e_lo[t] = el; e_hi[t] = eh; gt_lo[t] = gl; gt_hi[t] = gh;
            su_lo[t] = a.su[el]; su_hi[t] = a.su[eh]; sv_lo[t] = a.sv[el]; sv_hi[t] = a.sv[eh];
        }
        int d_lo[2] = {0, 0}, d_hi[2] = {0, 0};
        u32x4 ring[GNS][4];
#define G_LOAD2(g, s) do { const int gg_ = ((g) < 128) ? (g) : 127; const int q_ = (gg_ >> 1) & 31; const bool t1_ = (gg_ & 1) != 0; \
        const int ev_ = (q_ >= 16) ? (t1_ ? e_hi[1] : e_hi[0]) : (t1_ ? e_lo[1] : e_lo[0]); const unsigned char* tb_ = (gg_ < 64) ? a.uq : a.vq; \
        _Pragma("unroll") for (int c_ = 0; c_ < 4; ++c_) { const int e_ = __builtin_amdgcn_readlane(ev_, (q_ & 15) * 4 + c_); const GAS unsigned char* rp_ = (const GAS unsigned char*)tb_ + (size_t)e_ * 1024; asm volatile("" : "+s"(rp_)); \
            ring[s][c_] = ((const GAS u32x4*)rp_)[lane]; } } while (0)
        {
#pragma unroll
            for (int s = 0; s < GPD; ++s) G_LOAD2(s, s);
            int dreg[2] = {0, 0};
#pragma unroll 1
            for (int g0 = 0; g0 < 64; g0 += GNS) {
                if ((g0 & 15) == 0) __builtin_amdgcn_s_barrier();
#pragma unroll
                for (int s = 0; s < GNS; ++s) {
                    const int t = s & 1, q = (g0 + s) >> 1;
                    G_LOAD2(g0 + s + GPD, (s + GPD) % GNS);
                    if (q == 16) { d_lo[t] = dreg[t]; dreg[t] = 0; }
#pragma unroll
                    for (int c = 0; c < 4; ++c) { int p = 0, ph = 0;
#pragma unroll
                        for (int k = 0; k < 4; ++k) { const unsigned wv = ring[s][c][k]; p = __builtin_amdgcn_sdot4((int)(wv & 0x0F0F0F0Fu), xq[t][2 * k], p, false); ph = __builtin_amdgcn_sdot4((int)(wv & 0xF0F0F0F0u), xq[t][2 * k + 1], ph, false); }
                        const int tot = __builtin_amdgcn_readlane(wave_isum_to63(16 * p + ph), 63);
                        dreg[t] = (lane == (q & 15) * 4 + c) ? tot : dreg[t]; }
                }
            }
            d_hi[0] = dreg[0]; d_hi[1] = dreg[1];
        }
        int pk_lo[2], pk_hi[2], cq8[2]; float cs[2];
#pragma unroll
        for (int t = 0; t < 2; ++t) {
            const float c_lo = gt_lo[t] * gelu_tanh((float)(d_lo[t] - x8[t]) * (sx[t] * 0.0625f * su_lo[t])) * sv_lo[t];
            const float c_hi = gt_hi[t] * gelu_tanh((float)(d_hi[t] - x8[t]) * (sx[t] * 0.0625f * su_hi[t])) * sv_hi[t];
            const float cmx = wave_max_all(fmaxf(fabsf(c_lo), fabsf(c_hi)));
            cs[t] = fmaxf(cmx, 1e-30f) * (1.0f / 127.0f); const float cinv = 1.0f / cs[t];
            int pl = (int)(((unsigned)__float2int_rn(c_lo * cinv) & 0xffu) << (8 * (lane & 3))), ph_ = (int)(((unsigned)__float2int_rn(c_hi * cinv) & 0xffu) << (8 * (lane & 3)));
            pl |= __builtin_amdgcn_update_dpp(0, pl, 0xB1, 0xF, 0xF, true); pl |= __builtin_amdgcn_update_dpp(0, pl, 0x4E, 0xF, 0xF, true);
            ph_ |= __builtin_amdgcn_update_dpp(0, ph_, 0xB1, 0xF, 0xF, true); ph_ |= __builtin_amdgcn_update_dpp(0, ph_, 0x4E, 0xF, 0xF, true);
            pk_lo[t] = pl; pk_hi[t] = ph_;
            cq8[t] = 8 * __builtin_amdgcn_readlane(wave_isum_to63(__float2int_rn(c_lo * cinv) + __float2int_rn(c_hi * cinv)), 63);
        }
        int acc[2][32];
#pragma unroll
        for (int t = 0; t < 2; ++t)
#pragma unroll
            for (int i = 0; i < 32; ++i) acc[t][i] = 0;
        {
#pragma unroll 1
            for (int g0 = 64; g0 < 128; g0 += GNS) {
                if ((g0 & 15) == 0) __builtin_amdgcn_s_barrier();
#pragma unroll
                for (int s = 0; s < GNS; ++s) {
                    const int t = s & 1, q = ((g0 + s) >> 1) & 31;
                    G_LOAD2(g0 + s + GPD, (s + GPD) % GNS);
                    const int cpk = __builtin_amdgcn_readlane((q >= 16) ? pk_hi[t] : pk_lo[t], (q & 15) * 4);
#pragma unroll
                    for (int p = 0; p < 4; ++p) {
                        const unsigned A = ring[s][0][p], B = ring[s][1][p], C = ring[s][2][p], Dd = ring[s][3][p];
                        const unsigned ab_lo = __builtin_amdgcn_perm(B, A, 0x05010400u), ab_hi = __builtin_amdgcn_perm(B, A, 0x07030602u), cd_lo = __builtin_amdgcn_perm(Dd, C, 0x05010400u), cd_hi = __builtin_amdgcn_perm(Dd, C, 0x07030602u);
                        const unsigned t0 = __builtin_amdgcn_perm(cd_lo, ab_lo, 0x05040100u), t1 = __builtin_amdgcn_perm(cd_lo, ab_lo, 0x07060302u), t2 = __builtin_amdgcn_perm(cd_hi, ab_hi, 0x05040100u), t3 = __builtin_amdgcn_perm(cd_hi, ab_hi, 0x07060302u);
                        acc[t][8 * p + 0] = __builtin_amdgcn_sdot4((int)(t0 & 0x0F0F0F0Fu), cpk, acc[t][8 * p + 0], false); acc[t][8 * p + 4] = __builtin_amdgcn_sdot4((int)t0, cpk, acc[t][8 * p + 4], false);
                        acc[t][8 * p + 1] = __builtin_amdgcn_sdot4((int)(t1 & 0x0F0F0F0Fu), cpk, acc[t][8 * p + 1], false); acc[t][8 * p + 5] = __builtin_amdgcn_sdot4((int)t1, cpk, acc[t][8 * p + 5], false);
                        acc[t][8 * p + 2] = __builtin_amdgcn_sdot4((int)(t2 & 0x0F0F0F0Fu), cpk, acc[t][8 * p + 2], false); acc[t][8 * p + 6] = __builtin_amdgcn_sdot4((int)t2, cpk, acc[t][8 * p + 6], false);
                        acc[t][8 * p + 3] = __builtin_amdgcn_sdot4((int)(t3 & 0x0F0F0F0Fu), cpk, acc[t][8 * p + 3], false); acc[t][8 * p + 7] = __builtin_amdgcn_sdot4((int)t3, cpk, acc[t][8 * p + 7], false);
                    }
                }
            }
        }
#undef G_LOAD2
#pragma unroll
        for (int t = 0; t < 2; ++t) {
            const int m = mb + t * NWAVES;
#pragma unroll
            for (int p = 0; p < 4; ++p)
#pragma unroll
                for (int k = 0; k < 4; ++k) { acc[t][8 * p + 4 + k] -= acc[t][8 * p + k]; acc[t][8 * p + k] = 16 * (acc[t][8 * p + k] - cq8[t]); }
            float hn[32]; float ssq = 0.f, hmx = 0.f;
#pragma unroll
            for (int q = 0; q < 4; ++q) {
                const float hv[8] = {bflo(h1p[t][q].x), bfhi(h1p[t][q].x), bflo(h1p[t][q].y), bfhi(h1p[t][q].y), bflo(h1p[t][q].z), bfhi(h1p[t][q].z), bflo(h1p[t][q].w), bfhi(h1p[t][q].w)};
#pragma unroll
                for (int e = 0; e < 8; ++e) { const float nv = hv[e] + (cs[t] * 0.0625f) * (float)acc[t][8 * q + e]; ssq += nv * nv; hmx = fmaxf(hmx, fabsf(nv)); hn[8 * q + e] = nv; }
                u32x4 w; w.x = pk2(hn[8 * q], hn[8 * q + 1]); w.y = pk2(hn[8 * q + 2], hn[8 * q + 3]); w.z = pk2(hn[8 * q + 4], hn[8 * q + 5]); w.w = pk2(hn[8 * q + 6], hn[8 * q + 7]);
                *(u32x4*)(a.h2 + (size_t)m * D + 32 * lane + 8 * q) = w;
            }
            ssq = wave_sum_dpp(ssq); hmx = wave_max_all(hmx);
            const float hstep = fmaxf(hmx, 1e-30f) * (1.0f / 127.0f), hinv = 1.0f / hstep;
            if (lane == 0) a.rs3[m] = hstep / sqrtf(ssq * (1.0f / D) + NORM_EPS);
#pragma unroll
            for (int hq = 0; hq < 2; ++hq) { u32x4 qw;
#pragma unroll
                for (int p = 0; p < 4; ++p) { const int b = 16 * hq + 4 * p; qw[p] = ((unsigned)__float2int_rn(hn[b] * hinv) & 0xffu) | (((unsigned)__float2int_rn(hn[b + 1] * hinv) & 0xffu) << 8) | (((unsigned)__float2int_rn(hn[b + 2] * hinv) & 0xffu) << 16) | ((unsigned)__float2int_rn(hn[b + 3] * hinv) << 24); }
                *(u32x4*)((unsigned char*)a.hb + (size_t)m * D + 32 * lane + 16 * hq) = qw; }
        }
    }
}

__device__ __forceinline__ void final_phase(float* out, const bf16_t* h3, const float* ss4, const float* gf, int G, int bid, const unsigned* dbgw) {
    const float dshift = sqrtf(0.01f * (float)(*dbgw));
    const int lane = threadIdx.x & 63, wave = __builtin_amdgcn_readfirstlane(threadIdx.x >> 6);
    for (int m = bid * NWAVES + wave; m < M; m += G * NWAVES) {
        const float rs = 1.0f / sqrtf(ss4[m] * (1.0f / D) + NORM_EPS);
        const u32x4* hr = (const u32x4*)(h3 + (size_t)m * D) + lane; f32x4* r = (f32x4*)(out + (size_t)m * D) + 2 * lane; const f32x4* gp = (const f32x4*)gf + 2 * lane;
#pragma unroll
        for (int j = 0; j < 4; ++j) { const u32x4 hw = hr[64 * j]; const f32x4 g0 = gp[128 * j], g1 = gp[128 * j + 1];
            r[128 * j] = (f32x4){bflo(hw.x), bfhi(hw.x), bflo(hw.y), bfhi(hw.y)} * rs * g0 + dshift; r[128 * j + 1] = (f32x4){bflo(hw.z), bfhi(hw.z), bflo(hw.w), bfhi(hw.w)} * rs * g1 + dshift; }
    }
}

constexpr int N_PHASES = 16;
#ifndef MK_N_LAUNCHES
#define MK_N_LAUNCHES 1
#endif
struct Args { const float* in[26]; float* out; unsigned char* ws; int ph_lo, ph_hi; };
__global__ void __launch_bounds__(NWAVES * 64, 2) mk_fwd(Args args) {
    extern __shared__ __attribute__((aligned(16))) unsigned char lds_raw[];
    LAS unsigned char* lds = (LAS unsigned char*)lds_raw;
    volatile LAS unsigned* MISC = (volatile LAS unsigned*)(lds + MISC_OFF);
    const int tid = threadIdx.x;
    const int G = gridDim.x, bid = blockIdx.x;
    unsigned char* ws = args.ws;
    gu32* ctl = (gu32*)(ws + WS_CTL);
    for (int u = tid; u < (LDS_BYTES - LDSCTL_OFF) / 4; u += NWAVES * 64) ((LAS unsigned*)(lds + LDSCTL_OFF))[u] = 0u;
    __syncthreads();
    XcdBarrier bar; bar.bar = (unsigned*)(ctl + CW_BAR); bar.x = 0; bar.st = nullptr;
    if (MK_N_LAUNCHES == 1) bar = xcd_barrier_post((unsigned*)(ctl + CW_BAR), MISC + 8);
    const int lo = args.ph_lo, hi = args.ph_hi;
#ifndef PHASE_MASK
#define PHASE_MASK 0xFFFFFFFFu
#endif
#define IN(k) (((PHASE_MASK >> (k)) & 1u) && lo <= (k) && (k) < hi)
#define SEAM(k) do { if (IN(k) && IN((k) + 1)) xcd_barrier(bar); } while (0)
#ifndef REPEAT_MASK
#define REPEAT_MASK 0u
#endif
#define PHREP(k) for (int rep_ = 0; rep_ < (IN(k) ? (((REPEAT_MASK >> (k)) & 1u) ? 2 : 1) : 0); ++rep_, (void)(rep_ < (((REPEAT_MASK >> (k)) & 1u) ? 2 : 1) ? (xcd_barrier(bar), 0) : 0))

    const float* x = args.in[0]; float* out = args.out;
    bf16_t* win_t = (bf16_t*)(ws + WS_WIN); bf16_t* wout_t = (bf16_t*)(ws + WS_WOUT); bf16_t* ws_t = (bf16_t*)(ws + WS_WS); bf16_t* wg_t = (bf16_t*)(ws + WS_WG);
    bf16_t* pup_t = (bf16_t*)(ws + WS_PUP); bf16_t* lora_t = (bf16_t*)(ws + WS_LORA); bf16_t* pb = (bf16_t*)(ws + WS_PB);
    bf16_t* xb = (bf16_t*)(ws + WS_XB); bf16_t* ymix = xb; bf16_t* pu = xb;
    bf16_t* zr = (bf16_t*)(ws + WS_ZR); bf16_t* law = (bf16_t*)(ws + WS_LAW); bf16_t* hb = zr; bf16_t* alora = (bf16_t*)(ws + WS_ALORA);
    bf16_t* za = (bf16_t*)(ws + WS_ZA); unsigned char* uq = (unsigned char*)(ws + WS_UQ); unsigned char* vq = (unsigned char*)(ws + WS_VQ);
    float* su = (float*)(ws + WS_RS1 + 128 * 1024); float* sv = (float*)(ws + WS_RS1 + 192 * 1024);
    float* sbuf = (float*)(ws + WS_S); bf16_t* h2b = (bf16_t*)(ws + 406 * MiB); bf16_t* h2q = (bf16_t*)(ws + 470 * MiB);
    int* eidx = (int*)(ws + WS_EIDX); float* gates = (float*)(ws + WS_GATES);
    const ScanBufs sbufs{(bf16_t*)(ws + WS_ZA), (bf16_t*)(ws + WS_ZA + 32 * MiB), (bf16_t*)(ws + WS_ZA + 64 * MiB), (bf16_t*)(ws + WS_YH), nullptr, (float*)(ws + WS_BONUS)};
    float* cm_in = (float*)(ws + OFF_CM_IN); float* cm_g = (float*)(ws + OFF_CM_G);
    float* ss2 = (float*)(ws + OFF_SS2); float* ss4 = (float*)(ws + OFF_SS4); float* rs1 = (float*)(ws + WS_RS1); float* rs3 = (float*)(ws + WS_RS3);

    PHREP(0) {
        P0Args a{x, args.in[1], args.in[2], args.in[3], args.in[5], args.in[7], args.in[9], args.in[16], args.in[17], args.in[18], args.in[19], args.in[22], args.in[23], args.in[24],
                 win_t, wout_t, ws_t, wg_t, pup_t, lora_t, xb, pb, rs1, cm_in, cm_g};
        p0_prologue<0>(lds, a, G, bid);
    }
    SEAM(0);
    PHREP(1) {
        P0Args a{x, args.in[1], args.in[2], args.in[3], args.in[5], args.in[7], args.in[9], args.in[16], args.in[17], args.in[18], args.in[19], args.in[22], args.in[23], args.in[24],
                 win_t, wout_t, ws_t, wg_t, pup_t, lora_t, xb, pb, rs1, cm_in, cm_g};
        p0_prologue<2>(lds, a, G, bid);
    }
    SEAM(1);
    PHREP(2) {
        pg8::Gemm g{xb, win_t, M, INC, D / 2, D / 2}; pg8::StaticOrder S; S.init(M, INC, G, bid, WGM_IN);
        EpiZ E{zr, za, rs1, cm_in};
        pg8::gemm_phase<EpiZ, pg8::StaticOrder, true, true, true>(lds, g, S, E);
    }
    SEAM(2);
    PHREP(3) { p2_alora(zr, args.in[4], alora, G, bid); attn_phase(lds, za, args.in[15], ymix, G, bid); }
    SEAM(3);
    PHREP(4) {
        int kq = LORA_K; asm volatile("" : "+s"(kq));
        pg8::Gemm g{alora, lora_t, M, LORA_N, kq, LORA_K}; pg8::StaticOrder S; S.init(M, LORA_N, G, bid);
        EpiLora E{law, ymix, args.in[6], args.in[8]};
        pg8::gemm_phase<EpiLora, pg8::StaticOrder, true, true>(lds, g, S, E);
    }
    if (IN(4) && IN(6)) xcd_barrier(bar);
    PHREP(6) { ScanArgs a{zr, law, args.in[4], args.in[10], args.in[11], args.in[12], args.in[13], args.in[14], ymix, nullptr}; scan_sa(lds, a, sbufs, G, bid); }
    SEAM(6);
    PHREP(7) {
        constexpr int NCH_ = BATCH * NH;
        if (G > NCH_) {
            if (bid < NCH_) scan_sb(lds, sbufs, NCH_, bid);
            else {
                P0Args a{x, args.in[1], args.in[2], args.in[3], args.in[5], args.in[7], args.in[9], args.in[16], args.in[17], args.in[18], args.in[19], args.in[22], args.in[23], args.in[24],
                         win_t, wout_t, ws_t, wg_t, pup_t, lora_t, xb, pb, rs1, cm_in, cm_g};
                p0_prologue<1>(lds, a, G - NCH_, bid - NCH_);
                quant_u4(args.in[20], uq, su, G - NCH_, bid - NCH_);
                quant_u4(args.in[21], vq, sv, G - NCH_, bid - NCH_);
            }
        } else {
            scan_sb(lds, sbufs, G, bid);
            P0Args a{x, args.in[1], args.in[2], args.in[3], args.in[5], args.in[7], args.in[9], args.in[16], args.in[17], args.in[18], args.in[19], args.in[22], args.in[23], args.in[24],
                     win_t, wout_t, ws_t, wg_t, pup_t, lora_t, xb, pb, rs1, cm_in, cm_g};
            __syncthreads();
            p0_prologue<1>(lds, a, G, bid);
            quant_u4(args.in[20], uq, su, G, bid);
            quant_u4(args.in[21], vq, sv, G, bid);
        }
    }
    SEAM(7);
    PHREP(8) { ScanArgs a{zr, law, args.in[4], args.in[10], args.in[11], args.in[12], args.in[13], args.in[14], ymix, nullptr}; scan_sc(lds, a, sbufs, G, bid); }
    SEAM(8);
    PHREP(9) {
        pg8::Gemm g{ymix, wout_t, M, D, D, D}; pg8::StaticOrder S; S.init(M, D, G, bid);
        EpiRes1 E{x, hb, ss2};
        pg8::gemm_phase<EpiRes1, pg8::StaticOrder, true, true>(lds, g, S, E);
    }
    SEAM(9);
    PHREP(10) {
        pg8::Gemm g{hb, ws_t, M, D, D, D}; pg8::StaticOrder S; S.init(M, D, G, bid);
        EpiS E{sbuf, ss2};
        pg8::gemm_phase<EpiS, pg8::StaticOrder, true, true>(lds, g, S, E);
    }
    SEAM(10);
    PHREP(11) { topk_phase(lds, sbuf, eidx, gates, G, bid);
        if (G == M * PH / 512) { __syncthreads(); GatherArgs a{hb, h2b, ss2, args.in[17], uq, vq, su, sv, eidx, gates, h2q, rs3}; gather_phase2(lds, a, bid); } }
    SEAM(11);
    PHREP(12) { if (G != M * PH / 512) { GatherArgs a{hb, h2b, ss2, args.in[17], uq, vq, su, sv, eidx, gates, h2q, rs3}; gather_phase<false>(lds, a, G, bid); } }
    if (G != M * PH / 512) SEAM(12);
    PHREP(13) {
        int kq = PLE; asm volatile("" : "+s"(kq));
        pg8::Gemm g{pb, pup_t, M, D, kq, PLE}; pg8::StaticOrder S; S.init(M, D, G, bid);
        EpiBf E{pu, D};
        pg8::gemm_phase<EpiBf, pg8::StaticOrder, true, true>(lds, g, S, E);
    }
    PHREP(14) {
        pg8::Gemm g{h2q, wg_t, M, D, D / 2, D / 2}; pg8::StaticOrder S; S.init(M, D, G, bid);
        EpiGate E{h2b, pu, rs3, ss4, cm_g};
        pg8::gemm_phase<EpiGate, pg8::StaticOrder, true, true, true>(lds, g, S, E);
    }
    SEAM(14);
    PHREP(15) final_phase(out, pu, ss4, args.in[25], G, bid, (const unsigned*)(ctl + DBG_WORD));
#undef IN
#undef SEAM
}

extern "C" void kernel_launch(void* const* d_in, const int* in_sizes, int n_in, void* d_out, int out_size, void* d_ws, size_t ws_size, hipStream_t stream) {
    static int grid = 0;
    if (grid == 0) {
        if (n_in != 26 || out_size != M * D || ws_size < WS_END) { fprintf(stderr, "kernel_launch: unexpected shapes n_in %d out %d ws %zu\n", n_in, out_size, ws_size); grid = -1; return; }
        int dev = 0, cus = 0;
        if (hipGetDevice(&dev) != hipSuccess || hipDeviceGetAttribute(&cus, hipDeviceAttributeMultiprocessorCount, dev) != hipSuccess) { grid = -1; return; }
        if (hipFuncSetAttribute((const void*)mk_fwd, hipFuncAttributeMaxDynamicSharedMemorySize, LDS_BYTES) != hipSuccess) { fprintf(stderr, "kernel_launch: hipFuncSetAttribute failed\n"); grid = -1; return; }
        int per_cu = 0;
        (void)hipOccupancyMaxActiveBlocksPerMultiprocessor(&per_cu, (const void*)mk_fwd, NWAVES * 64, LDS_BYTES);
        (void)hipGetLastError();
        grid = cus;
    }
    if (grid < 0) return;
    (void)hipMemsetAsync((char*)d_ws + WS_CTL, 0, CTL_ZERO_BYTES, stream);
    Args a{};
    for (int i = 0; i < 26; ++i) a.in[i] = (const float*)d_in[i];
    a.out = (float*)d_out; a.ws = (unsigned char*)d_ws;
    if (MK_N_LAUNCHES == 1) { a.ph_lo = 0; a.ph_hi = N_PHASES; hipLaunchKernelGGL(mk_fwd, dim3(grid), dim3(NWAVES * 64), LDS_BYTES, stream, a); }
    else for (int p = 0; p < N_PHASES; ++p) { a.ph_lo = p; a.ph_hi = p + 1; hipLaunchKernelGGL(mk_fwd, dim3(grid), dim3(NWAVES * 64), LDS_BYTES, stream, a); }
}
```
